# Optimizing an MI355X kernel written in HIP

```python
import math
import jax, jax.numpy as jnp
from jax import lax
import numpy as np

D_MODEL = 2048
BATCH = 2
SEQ = 4096
DEPTH = 4

HEAD_DIM = 64
D_MIX = D_MODEL
N_MIX_HEADS = D_MIX // HEAD_DIM
N_CONV_GROUPS = N_MIX_HEADS // 4
N_FOX_HEADS = (N_MIX_HEADS - N_CONV_GROUPS) // 2
N_NSA_HEADS = N_MIX_HEADS - N_CONV_GROUPS - N_FOX_HEADS
NSA_GROUP = 4
N_NSA_KV = N_NSA_HEADS // NSA_GROUP
D_FOX = N_FOX_HEADS * HEAD_DIM
D_NSA = N_NSA_HEADS * HEAD_DIM
D_NSA_KV = N_NSA_KV * HEAD_DIM
D_CONV = N_CONV_GROUPS * HEAD_DIM
IN_SPLITS = (D_FOX, D_FOX, D_FOX, N_FOX_HEADS,
             D_NSA, D_NSA_KV, D_NSA_KV, D_NSA_KV, D_NSA_KV, D_NSA_KV, D_NSA_KV, 3 * N_NSA_HEADS,
             D_CONV, D_CONV)
D_IN = sum(IN_SPLITS)
D_FF = 4 * D_MODEL
Q_BLOCK = 128
CMP_LEN = 32
CMP_STRIDE = 16
SEL_LEN = 64
N_SEL = 16
WINDOW = 512
CONV_WIDTH = 31
N_BUCKETS = 32
MAX_DISTANCE = 128
EPS = 1e-6
NEG = -1e30
BIG = 1e9

kernel_name = "hybrid_fox_nsa_conformer_adaln_trunk"


def rms_norm(x, g):
    xf = x.astype(jnp.float32)
    y = xf * lax.rsqrt(jnp.mean(xf * xf, axis=-1, keepdims=True) + EPS)
    return (y * g.astype(jnp.float32)).astype(x.dtype)


def layer_norm(x, g, b):
    xf = x.astype(jnp.float32)
    mu = jnp.mean(xf, axis=-1, keepdims=True)
    var = jnp.mean(jnp.square(xf - mu), axis=-1, keepdims=True)
    y = (xf - mu) * lax.rsqrt(var + EPS) * g.astype(jnp.float32) + b.astype(jnp.float32)
    return y.astype(x.dtype)


def masked_softmax(s, mask):
    p = jax.nn.softmax(jnp.where(mask, s, NEG), axis=-1)
    return jnp.where(mask, p, 0.0)


def t5_bucket(dist):
    n = jnp.maximum(dist, 0)
    max_exact = N_BUCKETS // 2
    nf = jnp.maximum(n, 1).astype(jnp.float32)
    large = max_exact + (jnp.log(nf / max_exact) / math.log(MAX_DISTANCE / max_exact)
                         * (N_BUCKETS - max_exact)).astype(jnp.int32)
    large = jnp.minimum(large, N_BUCKETS - 1)
    return jnp.where(n < max_exact, n, large)


def qk_bias(table, dist):
    q_len, k_len = dist.shape
    b = table[t5_bucket(dist)]
    return b.reshape(q_len, k_len, N_NSA_KV, NSA_GROUP).transpose(2, 3, 0, 1)


def fox_attention(q, k, v, log_f):
    B, S, H, Dh = q.shape
    scale = Dh ** -0.5
    Fh = jnp.cumsum(log_f, axis=1).transpose(0, 2, 1)
    kpos = jnp.arange(S)

    def block(i):
        t0 = i * Q_BLOCK
        qpos = t0 + jnp.arange(Q_BLOCK)
        qb = lax.dynamic_slice_in_dim(q, t0, Q_BLOCK, axis=1)
        Fq = lax.dynamic_slice_in_dim(Fh, t0, Q_BLOCK, axis=2)
        s = jnp.einsum('bqhd,bkhd->bhqk', qb, k, preferred_element_type=jnp.float32) * scale
        s = s + Fq[..., :, None] - Fh[..., None, :]
        p = masked_softmax(s, kpos[None, :] <= qpos[:, None])
        return jnp.einsum('bhqk,bkhd->bqhd', p.astype(v.dtype), v)

    out = lax.map(block, jnp.arange(S // Q_BLOCK))
    return out.transpose(1, 0, 2, 3, 4).reshape(B, S, H * Dh)


def nsa_attention(q, kc, vc, ks, vs, kw, vw, gates, w_cmp_k, w_cmp_v, pos_cmp, rel_bias):
    B, S, H, Dh = q.shape
    G, R = N_NSA_KV, NSA_GROUP
    scale = Dh ** -0.5
    n_cmp = (S - CMP_LEN) // CMP_STRIDE + 1
    n_sel = S // SEL_LEN
    n_top = min(N_SEL, n_sel)
    T = n_top * SEL_LEN
    cidx = jnp.arange(n_cmp)[:, None] * CMP_STRIDE + jnp.arange(CMP_LEN)[None, :]
    cmp_end = cidx[:, -1]
    pos = pos_cmp[None, None, :, None, :]
    k_cmp = jnp.einsum('bnlgd,lde->bnge', kc[:, cidx] + pos, w_cmp_k)
    v_cmp = jnp.einsum('bnlgd,lde->bnge', vc[:, cidx] + pos, w_cmp_v)
    sel_start = jnp.arange(n_sel) * SEL_LEN
    overlap = ((cidx[:, 0][:, None] < sel_start[None, :] + SEL_LEN)
               & (cmp_end[:, None] >= sel_start[None, :])).astype(jnp.float32)
    ks_t = ks.transpose(0, 2, 1, 3)
    vs_t = vs.transpose(0, 2, 1, 3)
    pad = ((0, 0), (WINDOW, 0), (0, 0), (0, 0))
    kw_pad = jnp.pad(kw, pad)
    vw_pad = jnp.pad(vw, pad)
    table = rel_bias.astype(jnp.float32)
    tbl_g = table.reshape(N_BUCKETS, G, R).transpose(1, 0, 2)
    gates = gates.reshape(B, S, H, 3)
    gather = jax.vmap(jax.vmap(lambda a, ix: a[ix]))
    lookup = jax.vmap(lambda tb, bk: tb[bk], in_axes=(0, 1), out_axes=1)
    j = jnp.arange(n_sel)

    def block(i):
        t0 = i * Q_BLOCK
        qpos = t0 + jnp.arange(Q_BLOCK)
        qg = lax.dynamic_slice_in_dim(q, t0, Q_BLOCK, axis=1).reshape(B, Q_BLOCK, G, R, Dh)
        gb = lax.dynamic_slice_in_dim(gates, t0, Q_BLOCK, axis=1).reshape(B, Q_BLOCK, G, R, 3)
        s_c = jnp.einsum('bqgrd,bngd->bgrqn', qg, k_cmp, preferred_element_type=jnp.float32) * scale
        s_c = s_c + qk_bias(table, qpos[:, None] - cmp_end[None, :])
        p_c = masked_softmax(s_c, cmp_end[None, :] <= qpos[:, None])
        o_c = jnp.einsum('bgrqn,bngd->bqgrd', p_c.astype(v_cmp.dtype), v_cmp)
        imp = jnp.einsum('bgrqn,nj->bgqj', p_c, overlap)
        cur = qpos // SEL_LEN
        forced = (j[None, :] == 0) | (j[None, :] == cur[:, None]) | (j[None, :] == cur[:, None] - 1)
        valid = sel_start[None, :] <= qpos[:, None]
        imp = jnp.where(forced, BIG, jnp.where(valid, imp, NEG))
        _, top = lax.top_k(imp, n_top)
        tok = (top[..., None] * SEL_LEN + jnp.arange(SEL_LEN)).reshape(B, G, Q_BLOCK, T)
        flat = tok.reshape(B, G, Q_BLOCK * T)
        k_sel = gather(ks_t, flat).reshape(B, G, Q_BLOCK, T, Dh)
        v_sel = gather(vs_t, flat).reshape(B, G, Q_BLOCK, T, Dh)
        b_sel = lookup(tbl_g, t5_bucket(qpos[None, None, :, None] - tok))
        s_s = jnp.einsum('bqgrd,bgqtd->bgrqt', qg, k_sel, preferred_element_type=jnp.float32) * scale
        s_s = s_s + b_sel.transpose(0, 1, 4, 2, 3)
        p_s = masked_softmax(s_s, (tok <= qpos[None, None, :, None])[:, :, None])
        o_s = jnp.einsum('bgrqt,bgqtd->bqgrd', p_s.astype(v_sel.dtype), v_sel)
        kwb = lax.dynamic_slice_in_dim(kw_pad, t0, WINDOW + Q_BLOCK, axis=1)
        vwb = lax.dynamic_slice_in_dim(vw_pad, t0, WINDOW + Q_BLOCK, axis=1)
        kpos = t0 - WINDOW + jnp.arange(WINDOW + Q_BLOCK)
        dist = qpos[:, None] - kpos[None, :]
        s_w = jnp.einsum('bqgrd,bkgd->bgrqk', qg, kwb, preferred_element_type=jnp.float32) * scale
        s_w = s_w + qk_bias(table, dist)
        p_w = masked_softmax(s_w, (dist >= 0) & (dist < WINDOW) & (kpos[None, :] >= 0))
        o_w = jnp.einsum('bgrqk,bkgd->bqgrd', p_w.astype(vwb.dtype), vwb)
        g = jax.nn.sigmoid(gb.astype(jnp.float32))
        out = g[..., 0:1] * o_c + g[..., 1:2] * o_s + g[..., 2:3] * o_w
        return out.astype(q.dtype)

    out = lax.map(block, jnp.arange(S // Q_BLOCK))
    return out.transpose(1, 0, 2, 3, 4, 5).reshape(B, S, H * Dh)


def conformer_conv(a, gate, w_dw, b_dw, ln_g, ln_b):
    u = a * jax.nn.sigmoid(gate)
    y = lax.conv_general_dilated(u, w_dw[:, None, :], window_strides=(1,),
                                 padding=[(CONV_WIDTH - 1, 0)],
                                 dimension_numbers=('NWC', 'WIO', 'NWC'),
                                 feature_group_count=u.shape[-1])
    y = layer_norm(y + b_dw, ln_g, ln_b)
    return jax.nn.silu(y)


def split_in(z):
    pts = np.cumsum(np.array(IN_SPLITS))[:-1].tolist()
    return jnp.split(z, pts, axis=-1)


def setup_inputs(seed: int = 0) -> dict:
    key = jax.random.key(seed)
    ks = jax.random.split(key, 24)
    n = jax.random.normal
    f32 = jnp.float32
    L, Dh = CMP_LEN, HEAD_DIM
    return {
        "x": n(ks[0], (BATCH, SEQ, D_MODEL), f32),
        "c": n(ks[1], (BATCH, D_MODEL), f32),
        "w_mod": n(ks[2], (DEPTH, D_MODEL, 6 * D_MODEL), f32) * (0.5 * D_MODEL ** -0.5),
        "b_mod": n(ks[3], (DEPTH, 6 * D_MODEL), f32) * 0.02,
        "norm1_g": 1.0 + 0.05 * n(ks[4], (DEPTH, D_MODEL), f32),
        "w_in": n(ks[5], (DEPTH, D_MODEL, D_IN), f32) * D_MODEL ** -0.5,
        "b_f": jax.random.uniform(ks[6], (DEPTH, N_FOX_HEADS), f32, 3.0, 6.0),
        "w_cmp_k": n(ks[7], (DEPTH, L, Dh, Dh), f32) * (L * Dh) ** -0.5,
        "w_cmp_v": n(ks[8], (DEPTH, L, Dh, Dh), f32) * (L * Dh) ** -0.5,
        "pos_cmp": n(ks[9], (DEPTH, L, Dh), f32) * 0.5,
        "conv_w": n(ks[10], (DEPTH, CONV_WIDTH, D_CONV), f32) * CONV_WIDTH ** -0.5,
        "conv_b": n(ks[11], (DEPTH, D_CONV), f32) * 0.02,
        "conv_ln_g": 1.0 + 0.05 * n(ks[12], (DEPTH, D_CONV), f32),
        "conv_ln_b": n(ks[13], (DEPTH, D_CONV), f32) * 0.02,
        "w_out": n(ks[14], (DEPTH, D_MIX, D_MODEL), f32) * D_MIX ** -0.5,
        "norm2_g": 1.0 + 0.05 * n(ks[15], (DEPTH, D_MODEL), f32),
        "w_mlp1": n(ks[16], (DEPTH, D_MODEL, D_FF), f32) * D_MODEL ** -0.5,
        "w_mlp2": n(ks[17], (DEPTH, D_FF, D_MODEL), f32) * D_FF ** -0.5,
        "rel_bias": n(ks[18], (N_BUCKETS, N_NSA_HEADS), f32) * 0.5,
        "final_g": 1.0 + 0.05 * n(ks[19], (D_MODEL,), f32),
    }


def reference(x, c, w_mod, b_mod, norm1_g, w_in, b_f, w_cmp_k, w_cmp_v, pos_cmp,
              conv_w, conv_b, conv_ln_g, conv_ln_b, w_out, norm2_g, w_mlp1, w_mlp2,
              rel_bias, final_g):
    B, S, _ = x.shape
    c_act = jax.nn.silu(c)
    for l in range(DEPTH):
        mod = (c_act @ w_mod[l] + b_mod[l])[:, None, :]
        sh1, sc1, g1, sh2, sc2, g2 = jnp.split(mod, 6, axis=-1)
        h = rms_norm(x, norm1_g[l]) * (1.0 + sc1) + sh1
        (fq, fk, fv, ff, nq, kc, vc, ksl, vsl, kwn, vwn, ng, ca, cg) = split_in(h @ w_in[l])
        hd = lambda t: t.reshape(B, S, -1, HEAD_DIM)
        log_f = jax.nn.log_sigmoid(ff.astype(jnp.float32) + b_f[l].astype(jnp.float32))
        o_fox = fox_attention(hd(fq), hd(fk), hd(fv), log_f)
        o_nsa = nsa_attention(hd(nq), hd(kc), hd(vc), hd(ksl), hd(vsl), hd(kwn), hd(vwn), ng,
                              w_cmp_k[l], w_cmp_v[l], pos_cmp[l], rel_bias)
        o_conv = conformer_conv(ca, cg, conv_w[l], conv_b[l], conv_ln_g[l], conv_ln_b[l])
        mixed = jnp.concatenate([o_fox, o_nsa, o_conv], axis=-1)
        x = x + g1 * (mixed @ w_out[l])
        h = rms_norm(x, norm2_g[l]) * (1.0 + sc2) + sh2
        x = x + g2 * (jnp.square(jax.nn.relu(h @ w_mlp1[l])) @ w_mlp2[l])
    return rms_norm(x, final_g)
```

```cpp
#include <hip/hip_runtime.h>
#include <math.h>
#include <stdint.h>

namespace nv {
constexpr int D = 2048, NB = 2, S = 4096, NL = 4, M = NB * S, DIN = 5296, DFF = 8192, MODW = 6 * D;
constexpr int C_FQ = 0, C_FK = 768, C_FV = 1536, C_FF = 2304, C_NQ = 2316, C_KC = 3084, C_VC = 3276, C_KS = 3468, C_VS = 3660, C_KW = 3852, C_VW = 4044, C_NG = 4236, C_CA = 4272, C_CG = 4784;
constexpr int NCMP = 255;

__device__ __forceinline__ float sigm(float x) { return 1.f / (1.f + expf(-x)); }
__device__ __forceinline__ int t5_bucket(int dist) {
    int n = dist > 0 ? dist : 0;
    if (n < 16) return n;
    float nf = (float)n;
    int large = 16 + (int)(logf(nf / 16.0f) / 2.0794415416798357f * 16.0f);
    return large < 31 ? large : 31;
}
__device__ __forceinline__ float wave_max(float v) { for (int o = 32; o; o >>= 1) v = fmaxf(v, __shfl_xor(v, o)); return v; }
__device__ __forceinline__ float wave_sum(float v) { for (int o = 32; o; o >>= 1) v += __shfl_xor(v, o); return v; }

__global__ void __launch_bounds__(256) k_mod(const float* c, const float* w_mod, const float* b_mod, float* mod) {
    __shared__ float ca[2][D];
    const int j = blockIdx.x * 256 + threadIdx.x, l = blockIdx.y;
    for (int i = threadIdx.x; i < 2 * D; i += 256) { float v = c[i]; ca[i / D][i % D] = v * sigm(v); }
    __syncthreads();
    float a0 = 0.f, a1 = 0.f; const float* w = w_mod + (size_t)l * D * MODW + j;
    for (int k = 0; k < D; ++k) { float wv = w[(size_t)k * MODW]; a0 += ca[0][k] * wv; a1 += ca[1][k] * wv; }
    mod[(l * 2 + 0) * MODW + j] = a0 + b_mod[l * MODW + j];
    mod[(l * 2 + 1) * MODW + j] = a1 + b_mod[l * MODW + j];
}
__global__ void __launch_bounds__(256) k_norm(const float* x, const float* g, const float* modl, int sh_off, int sc_off, float* out) {
    __shared__ float red[4];
    const int row = blockIdx.x, b = row / S, tid = threadIdx.x;
    const float* xr = x + (size_t)row * D; float v[8]; float ss = 0.f;
#pragma unroll
    for (int i = 0; i < 8; ++i) { v[i] = xr[tid + 256 * i]; ss += v[i] * v[i]; }
    ss = wave_sum(ss); if ((tid & 63) == 0) red[tid >> 6] = ss; __syncthreads();
    const float tot = red[0] + red[1] + red[2] + red[3]; const float rs = rsqrtf(tot / D + 1e-6f);
#pragma unroll
    for (int i = 0; i < 8; ++i) { const int col = tid + 256 * i; float y = v[i] * rs * g[col];
        if (modl) y = y * (1.f + modl[b * MODW + sc_off + col]) + modl[b * MODW + sh_off + col];
        out[(size_t)row * D + col] = y; }
}
template <int EPI> __global__ void __launch_bounds__(256) k_gemm(const float* __restrict__ A, const float* __restrict__ Bm, float* C, int Mm, int N, int K, const float* base, const float* gate) {
    __shared__ float As[16][68], Bs[16][68];
    const int tid = threadIdx.x, tx = tid & 15, ty = tid >> 4, row0 = blockIdx.y * 64, col0 = blockIdx.x * 64;
    float acc[4][4];
#pragma unroll
    for (int i = 0; i < 4; ++i)
#pragma unroll
        for (int j = 0; j < 4; ++j) acc[i][j] = 0.f;
    const int ar = tid >> 2, ak = (tid & 3) * 4, bk = tid >> 4, bc = (tid & 15) * 4;
    for (int k0 = 0; k0 < K; k0 += 16) {
        const float4 av = *(const float4*)(A + (size_t)(row0 + ar) * K + k0 + ak);
        float4 bv = make_float4(0.f, 0.f, 0.f, 0.f);
        if (col0 + bc < N) bv = *(const float4*)(Bm + (size_t)(k0 + bk) * N + col0 + bc);
        __syncthreads();
        As[ak + 0][ar] = av.x; As[ak + 1][ar] = av.y; As[ak + 2][ar] = av.z; As[ak + 3][ar] = av.w;
        Bs[bk][bc + 0] = bv.x; Bs[bk][bc + 1] = bv.y; Bs[bk][bc + 2] = bv.z; Bs[bk][bc + 3] = bv.w;
        __syncthreads();
#pragma unroll
        for (int kk = 0; kk < 16; ++kk) {
            float a[4], bb[4];
#pragma unroll
            for (int i = 0; i < 4; ++i) { a[i] = As[kk][ty * 4 + i]; bb[i] = Bs[kk][tx * 4 + i]; }
#pragma unroll
            for (int i = 0; i < 4; ++i)
#pragma unroll
                for (int j = 0; j < 4; ++j) acc[i][j] += a[i] * bb[j];
        }
    }
#pragma unroll
    for (int i = 0; i < 4; ++i) { const int row = row0 + ty * 4 + i; const int b = row / S;
#pragma unroll
        for (int j = 0; j < 4; ++j) { const int col = col0 + tx * 4 + j; if (col >= N) continue; float v = acc[i][j];
            if (EPI == 1) v = base[(size_t)row * N + col] + gate[b * MODW + col] * v;
            if (EPI == 2) { v = v > 0.f ? v : 0.f; v = v * v; }
            C[(size_t)row * N + col] = v; } }
}
__global__ void __launch_bounds__(256) k_cumsum(const float* Z, const float* bf, float* F) {
    __shared__ float sc[256];
    const int bh = blockIdx.x, b = bh / 12, h = bh % 12, tid = threadIdx.x, t0 = tid * 16;
    float run = 0.f;
    for (int i = 0; i < 16; ++i) { float x = Z[(size_t)(b * S + t0 + i) * DIN + C_FF + h] + bf[h]; run += x >= 0.f ? -log1pf(expf(-x)) : x - log1pf(expf(x)); }
    sc[tid] = run; __syncthreads();
    float off = 0.f; for (int k = 0; k < tid; ++k) off += sc[k];
    run = off;
    for (int i = 0; i < 16; ++i) { float x = Z[(size_t)(b * S + t0 + i) * DIN + C_FF + h] + bf[h]; run += x >= 0.f ? -log1pf(expf(-x)) : x - log1pf(expf(x)); F[(size_t)bh * S + t0 + i] = run; }
}
__global__ void __launch_bounds__(64) k_compress(const float* Z, const float* wk, const float* wv, const float* pos, float* KC, float* VC) {
    const int idx = blockIdx.x, g = idx % 3, n = (idx / 3) % NCMP, b = idx / (3 * NCMP), e = threadIdx.x;
    float ak = 0.f, av = 0.f;
    for (int l = 0; l < 32; ++l) { const float* zr = Z + (size_t)(b * S + 16 * n + l) * DIN;
        for (int d = 0; d < 64; ++d) { const float pk = pos[l * 64 + d]; ak += (zr[C_KC + g * 64 + d] + pk) * wk[(l * 64 + d) * 64 + e]; av += (zr[C_VC + g * 64 + d] + pk) * wv[(l * 64 + d) * 64 + e]; } }
    KC[(size_t)idx * 64 + e] = ak; VC[(size_t)idx * 64 + e] = av;
}
__device__ __forceinline__ float dot64(const float* q, const float* k) { float a = 0.f;
#pragma unroll 16
    for (int d = 0; d < 64; ++d) a += q[d] * k[d]; return a; }
__global__ void __launch_bounds__(64) k_nsa(const float* Z, const float* KC, const float* VC, const float* relb, float* MIX) {
    __shared__ float q[4][64]; __shared__ float sc[4][1024]; __shared__ float impv[64];
    const int idx = blockIdx.x, t = idx % S, g = (idx / S) % 3, b = idx / (3 * S), lane = threadIdx.x;
    const float* zrow = Z + (size_t)(b * S + t) * DIN;
    for (int r = 0; r < 4; ++r) q[r][lane] = zrow[C_NQ + (g * 4 + r) * 64 + lane];
    __syncthreads();
    float oc[4], os[4], ow[4];
    const int nvalid = t >= 31 ? ((t - 31) / 16 + 1 < NCMP ? (t - 31) / 16 + 1 : NCMP) : 0;
    for (int n = lane; n < 256; n += 64)
        for (int r = 0; r < 4; ++r) { float s = -INFINITY;
            if (n < nvalid) s = dot64(q[r], KC + (size_t)((b * NCMP + n) * 3 + g) * 64) * 0.125f + relb[t5_bucket(t - (16 * n + 31)) * 12 + g * 4 + r];
            sc[r][n] = s; }
    __syncthreads();
    for (int r = 0; r < 4; ++r) { float m = -INFINITY; for (int n = lane; n < 256; n += 64) m = fmaxf(m, sc[r][n]); m = wave_max(m);
        float e[4], sum = 0.f;
#pragma unroll
        for (int i = 0; i < 4; ++i) { const float s = sc[r][lane + 64 * i]; e[i] = (s == -INFINITY) ? 0.f : expf(s - m); sum += e[i]; }
        sum = wave_sum(sum); const float inv = sum > 0.f ? 1.f / sum : 0.f;
#pragma unroll
        for (int i = 0; i < 4; ++i) sc[r][lane + 64 * i] = e[i] * inv; }
    __syncthreads();
    for (int r = 0; r < 4; ++r) { float a = 0.f; for (int n = 0; n < nvalid; ++n) a += sc[r][n] * VC[(size_t)((b * NCMP + n) * 3 + g) * 64 + lane]; oc[r] = a; }
    { float im = 0.f; for (int r = 0; r < 4; ++r) for (int n = 4 * lane - 1; n <= 4 * lane + 3; ++n) if (n >= 0 && n < NCMP) im += sc[r][n];
      const int cur = t / 64; const bool forced = (lane == 0) || (lane == cur) || (lane == cur - 1); const bool valid = 64 * lane <= t;
      impv[lane] = forced ? 1e9f : (valid ? im : -1e30f); }
    __syncthreads();
    unsigned long long selm;
    { const float val = impv[lane]; int rank = 0; for (int k = 0; k < 64; ++k) { const float o = impv[k]; rank += (o > val || (o == val && k < lane)) ? 1 : 0; }
      selm = __ballot(rank < 16 && 64 * lane <= t); }
    __syncthreads();
    int nslot = 0;
    for (unsigned long long mm = selm; mm; mm &= mm - 1) { const int j = __builtin_ctzll(mm); const int tok = 64 * j + lane;
        for (int r = 0; r < 4; ++r) { float s = -INFINITY;
            if (tok <= t) s = dot64(q[r], Z + (size_t)(b * S + tok) * DIN + C_KS + g * 64) * 0.125f + relb[t5_bucket(t - tok) * 12 + g * 4 + r];
            sc[r][nslot * 64 + lane] = s; }
        ++nslot; }
    __syncthreads();
    for (int r = 0; r < 4; ++r) { float m = -INFINITY; for (int p = 0; p < nslot; ++p) m = fmaxf(m, sc[r][p * 64 + lane]); m = wave_max(m);
        float sum = 0.f; for (int p = 0; p < nslot; ++p) { const float s = sc[r][p * 64 + lane]; const float e = (s == -INFINITY) ? 0.f : expf(s - m); sc[r][p * 64 + lane] = e; sum += e; }
        sum = wave_sum(sum); const float inv = sum > 0.f ? 1.f / sum : 0.f;
        for (int p = 0; p < nslot; ++p) sc[r][p * 64 + lane] *= inv; }
    __syncthreads();
    for (int r = 0; r < 4; ++r) os[r] = 0.f;
    { int p = 0; for (unsigned long long mm = selm; mm; mm &= mm - 1, ++p) { const int j = __builtin_ctzll(mm);
        for (int kk = 0; kk < 64; ++kk) { const float vv = Z[(size_t)(b * S + 64 * j + kk) * DIN + C_VS + g * 64 + lane];
#pragma unroll
            for (int r = 0; r < 4; ++r) os[r] += sc[r][p * 64 + kk] * vv; } } }
    __syncthreads();
    for (int i = 0; i < 8; ++i) { const int s_ = t - 511 + lane + 64 * i;
        for (int r = 0; r < 4; ++r) { float s = -INFINITY;
            if (s_ >= 0) s = dot64(q[r], Z + (size_t)(b * S + s_) * DIN + C_KW + g * 64) * 0.125f + relb[t5_bucket(t - s_) * 12 + g * 4 + r];
            sc[r][i * 64 + lane] = s; } }
    __syncthreads();
    for (int r = 0; r < 4; ++r) { float m = -INFINITY; for (int p = 0; p < 8; ++p) m = fmaxf(m, sc[r][p * 64 + lane]); m = wave_max(m);
        float sum = 0.f; for (int p = 0; p < 8; ++p) { const float s = sc[r][p * 64 + lane]; const float e = (s == -INFINITY) ? 0.f : expf(s - m); sc[r][p * 64 + lane] = e; sum += e; }
        sum = wave_sum(sum); const float inv = sum > 0.f ? 1.f / sum : 0.f;
        for (int p = 0; p < 8; ++p) sc[r][p * 64 + lane] *= inv; }
    __syncthreads();
    for (int r = 0; r < 4; ++r) ow[r] = 0.f;
    for (int kk = 0; kk < 512; ++kk) { const int s_ = t - 511 + kk; if (s_ < 0) continue; const float vv = Z[(size_t)(b * S + s_) * DIN + C_VW + g * 64 + lane];
#pragma unroll
        for (int r = 0; r < 4; ++r) ow[r] += sc[r][kk] * vv; }
    for (int r = 0; r < 4; ++r) { const int h = g * 4 + r; const float g0 = sigm(zrow[C_NG + h * 3 + 0]), g1 = sigm(zrow[C_NG + h * 3 + 1]), g2 = sigm(zrow[C_NG + h * 3 + 2]);
        MIX[(size_t)(b * S + t) * D + 768 + h * 64 + lane] = g0 * oc[r] + g1 * os[r] + g2 * ow[r]; }
}
__global__ void __launch_bounds__(64) k_fox(const float* Z, const float* F, float* MIX) {
    __shared__ float q[64]; __shared__ float sc[S];
    const int idx = blockIdx.x, t = idx % S, h = (idx / S) % 12, b = idx / (12 * S), lane = threadIdx.x;
    q[lane] = Z[(size_t)(b * S + t) * DIN + C_FQ + h * 64 + lane];
    __syncthreads();
    const float* Fh = F + (size_t)(b * 12 + h) * S; const float Ft = Fh[t];
    float m = -INFINITY;
    for (int s = lane; s <= t; s += 64) { const float v = dot64(q, Z + (size_t)(b * S + s) * DIN + C_FK + h * 64) * 0.125f + Ft - Fh[s]; sc[s] = v; m = fmaxf(m, v); }
    m = wave_max(m); float sum = 0.f;
    for (int s = lane; s <= t; s += 64) { const float e = expf(sc[s] - m); sc[s] = e; sum += e; }
    sum = wave_sum(sum);
    __syncthreads();
    float o = 0.f; for (int s = 0; s <= t; ++s) o += sc[s] * Z[(size_t)(b * S + s) * DIN + C_FV + h * 64 + lane];
    MIX[(size_t)(b * S + t) * D + h * 64 + lane] = o / sum;
}
__global__ void __launch_bounds__(512) k_conv(const float* Z, const float* w, const float* bias, const float* lg, const float* lb, float* MIX) {
    __shared__ float red[8]; __shared__ float red2[8];
    const int row = blockIdx.x, b = row / S, t = row % S, c = threadIdx.x;
    float y = 0.f;
    for (int k = 0; k < 31; ++k) { const int tt = t - 30 + k; if (tt < 0) continue; const float* zr = Z + (size_t)(b * S + tt) * DIN; y += zr[C_CA + c] * sigm(zr[C_CG + c]) * w[k * 512 + c]; }
    y += bias[c];
    float s1 = wave_sum(y); if ((c & 63) == 0) red[c >> 6] = s1; __syncthreads();
    float mu = 0.f; for (int i = 0; i < 8; ++i) mu += red[i]; mu *= (1.f / 512.f);
    const float dy = y - mu; float s2 = wave_sum(dy * dy); if ((c & 63) == 0) red2[c >> 6] = s2; __syncthreads();
    float var = 0.f; for (int i = 0; i < 8; ++i) var += red2[i]; var *= (1.f / 512.f);
    const float yn = dy * rsqrtf(var + 1e-6f) * lg[c] + lb[c];
    MIX[(size_t)row * D + 1536 + c] = yn * sigm(yn);
}
}

extern "C" void kernel_launch(void* const* d_in, const int* in_sizes, int n_in, void* d_out, int out_size, void* d_ws, size_t ws_size, hipStream_t stream) {
    using namespace nv;
    const float* x = (const float*)d_in[0]; const float* c = (const float*)d_in[1]; const float* w_mod = (const float*)d_in[2]; const float* b_mod = (const float*)d_in[3];
    const float* norm1_g = (const float*)d_in[4]; const float* w_in = (const float*)d_in[5]; const float* b_f = (const float*)d_in[6]; const float* w_cmp_k = (const float*)d_in[7];
    const float* w_cmp_v = (const float*)d_in[8]; const float* pos_cmp = (const float*)d_in[9]; const float* conv_w = (const float*)d_in[10]; const float* conv_b = (const float*)d_in[11];
    const float* conv_ln_g = (const float*)d_in[12]; const float* conv_ln_b = (const float*)d_in[13]; const float* w_out = (const float*)d_in[14]; const float* norm2_g = (const float*)d_in[15];
    const float* w_mlp1 = (const float*)d_in[16]; const float* w_mlp2 = (const float*)d_in[17]; const float* rel_bias = (const float*)d_in[18]; const float* final_g = (const float*)d_in[19];
    float* ws = (float*)d_ws; size_t off = 0;
    auto take = [&](size_t n) { float* p = ws + off; off += (n + 63) & ~(size_t)63; return p; };
    float* MOD = take((size_t)NL * 2 * MODW); float* X = take((size_t)M * D); float* H = take((size_t)M * D); float* Z = take((size_t)M * DIN);
    float* F = take((size_t)NB * 12 * S); float* KC = take((size_t)NB * NCMP * 3 * 64); float* VC = take((size_t)NB * NCMP * 3 * 64); float* MIX = take((size_t)M * D); float* HB = take((size_t)M * DFF);
    hipLaunchKernelGGL(k_mod, dim3(MODW / 256, NL), dim3(256), 0, stream, c, w_mod, b_mod, MOD);
    const float* xin = x;
    for (int l = 0; l < NL; ++l) {
        const float* modl = MOD + (size_t)l * 2 * MODW;
        hipLaunchKernelGGL(k_norm, dim3(M), dim3(256), 0, stream, xin, norm1_g + l * D, modl, 0, D, H);
        hipLaunchKernelGGL(k_gemm<0>, dim3((DIN + 63) / 64, M / 64), dim3(256), 0, stream, H, w_in + (size_t)l * D * DIN, Z, M, DIN, D, (const float*)nullptr, (const float*)nullptr);
        hipLaunchKernelGGL(k_cumsum, dim3(NB * 12), dim3(256), 0, stream, Z, b_f + l * 12, F);
        hipLaunchKernelGGL(k_compress, dim3(NB * NCMP * 3), dim3(64), 0, stream, Z, w_cmp_k + (size_t)l * 32 * 64 * 64, w_cmp_v + (size_t)l * 32 * 64 * 64, pos_cmp + l * 32 * 64, KC, VC);
        hipLaunchKernelGGL(k_fox, dim3(NB * 12 * S), dim3(64), 0, stream, Z, F, MIX);
        hipLaunchKernelGGL(k_nsa, dim3(NB * 3 * S), dim3(64), 0, stream, Z, KC, VC, rel_bias, MIX);
        hipLaunchKernelGGL(k_conv, dim3(M), dim3(512), 0, stream, Z, conv_w + (size_t)l * 31 * 512, conv_b + l * 512, conv_ln_g + l * 512, conv_ln_b + l * 512, MIX);
        hipLaunchKernelGGL(k_gemm<1>, dim3(D / 64, M / 64), dim3(256), 0, stream, MIX, w_out + (size_t)l * D * D, X, M, D, D, xin, modl + 2 * D);
        hipLaunchKernelGGL(k_norm, dim3(M), dim3(256), 0, stream, X, norm2_g + l * D, modl, 3 * D, 4 * D, H);
        hipLaunchKernelGGL(k_gemm<2>, dim3(DFF / 64, M / 64), dim3(256), 0, stream, H, w_mlp1 + (size_t)l * D * DFF, HB, M, DFF, D, (const float*)nullptr, (const float*)nullptr);
        hipLaunchKernelGGL(k_gemm<1>, dim3(D / 64, M / 64), dim3(256), 0, stream, HB, w_mlp2 + (size_t)l * DFF * D, X, M, D, DFF, X, modl + 5 * D);
        xin = X;
    }
    hipLaunchKernelGGL(k_norm, dim3(M), dim3(256), 0, stream, X, final_g, (const float*)nullptr, 0, 0, (float*)d_out);
}
```

```cpp
#include <hip/hip_runtime.h>
#include <cstdio>
#include <cstdint>
#include <math.h>
#define MK_MODE 0
namespace pg8 {
#define PG8_LAS __attribute__((address_space(3)))
typedef unsigned short bf16_t;
typedef short bf16x8 __attribute__((ext_vector_type(8)));
typedef float f32x4 __attribute__((ext_vector_type(4)));
typedef unsigned u32x4 __attribute__((ext_vector_type(4)));
constexpr int BM = 256, BK = 64, HALF = 128, HTB = HALF * BK * 2  , STAGE_BYTES = 8 * HTB, NXCD = 8, WGM = 8;

__host__ __device__ __forceinline__ int lds_byte(int r, int c) { const int st = (r >> 4) * 2 + (c >> 5), rr = r & 15, cc = c & 31, ob = rr * 64 + cc * 2; return st * 1024 + (ob ^ (((ob >> 9) & 1) << 5)); }
__host__ __device__ __forceinline__ void stage_rc(int b, int& R, int& C) { const int st = b / 1024, sb = b % 1024, swz = sb ^ (((sb >> 9) & 1) << 5); R = (st >> 1) * 16 + swz / 64; C = (st & 1) * 32 + (swz % 64) / 2; }
__host__ __device__ __forceinline__ int perm32(int rho) { const int n = rho >> 4, i = rho & 15; return 8 * (i >> 2) + 4 * n + (i & 3); }

struct Unit { int pm, pn; };
struct Gemm { const bf16_t* A; const bf16_t* Bt; int M, N, K; };

struct StaticOrder {
    int nM, nN, nwg, G, c;
    __host__ __device__ void init(int M, int N, int G_, int c_) { nM = M / BM; nN = N / BM; nwg = nM * nN; G = G_; c = c_; }
    __host__ __device__ bool next(int i, Unit& u) const {
        const long L = (long)i * G + c; if (L >= nwg) return false;
        int wgid = (int)L; { const int q = nwg / NXCD, r = nwg % NXCD, xcd = wgid % NXCD, off = wgid / NXCD; wgid = (xcd < r ? xcd * (q + 1) : r * (q + 1) + (xcd - r) * q) + off; }
        const int nig = WGM * nN, gid = wgid / nig, fm = gid * WGM, gsz = (nM - fm) < WGM ? (nM - fm) : WGM;
        u.pm = fm + ((wgid % nig) % gsz); u.pn = (wgid % nig) / gsz; return true;
    }
    __device__ __forceinline__ void a_ready(const Unit&) const {}
    __device__ __forceinline__ void done(const Unit&) const {}
};

__device__ __forceinline__ unsigned cvt_pk_bf16(float lo, float hi) { unsigned r; asm volatile("v_cvt_pk_bf16_f32 %0, %1, %2" : "=v"(r) : "v"(lo), "v"(hi)); return r; }
typedef float f32x2 __attribute__((ext_vector_type(2)));
struct EpiZ {
    static constexpr bool PERM = true, AFTER_DRAIN = false;
    bf16_t* O; int ldc; unsigned scale_mask; float sc;
    __device__ __forceinline__ void operator()(const f32x4 (&acc)[2][2][4][2], const Unit& u, int wr, int wc, int fr, int fq) const {
        const int row0 = u.pm * BM + wr * 64 + fr; const int col0 = u.pn * BM + wc * 32 + 8 * fq;
        const float s = ((scale_mask >> u.pn) & 1u) ? sc : 1.f;
#pragma unroll
        for (int ai = 0; ai < 2; ++ai)
#pragma unroll
            for (int m = 0; m < 4; ++m) { bf16_t* rowp = O + (size_t)(row0 + ai * HALF + m * 16) * ldc + col0;
#pragma unroll
                for (int bj = 0; bj < 2; ++bj) { const f32x4 v0 = acc[ai][bj][m][0] * s, v1 = acc[ai][bj][m][1] * s;
                    u32x4 w; w.x = cvt_pk_bf16(v0[0], v0[1]); w.y = cvt_pk_bf16(v0[2], v0[3]); w.z = cvt_pk_bf16(v1[0], v1[1]); w.w = cvt_pk_bf16(v1[2], v1[3]);
                    *(u32x4*)(rowp + bj * HALF) = w; } }
    }
};
struct EpiRelu2 {
    static constexpr bool PERM = true, AFTER_DRAIN = false;
    bf16_t* O; int ldc;
    __device__ __forceinline__ void operator()(const f32x4 (&acc)[2][2][4][2], const Unit& u, int wr, int wc, int fr, int fq) const {
        const int row0 = u.pm * BM + wr * 64 + fr; const int col0 = u.pn * BM + wc * 32 + 8 * fq;
#pragma unroll
        for (int ai = 0; ai < 2; ++ai)
#pragma unroll
            for (int m = 0; m < 4; ++m) { bf16_t* rowp = O + (size_t)(row0 + ai * HALF + m * 16) * ldc + col0;
#pragma unroll
                for (int bj = 0; bj < 2; ++bj) { f32x4 v0 = acc[ai][bj][m][0], v1 = acc[ai][bj][m][1];
#pragma unroll
                    for (int i = 0; i < 4; ++i) { v0[i] = v0[i] > 0.f ? v0[i] : 0.f; v1[i] = v1[i] > 0.f ? v1[i] : 0.f; }
                    v0 = v0 * v0; v1 = v1 * v1;
                    u32x4 w; w.x = cvt_pk_bf16(v0[0], v0[1]); w.y = cvt_pk_bf16(v0[2], v0[3]); w.z = cvt_pk_bf16(v1[0], v1[1]); w.w = cvt_pk_bf16(v1[2], v1[3]);
                    *(u32x4*)(rowp + bj * HALF) = w; } }
    }
};
struct EpiResGate {
    static constexpr bool PERM = false, AFTER_DRAIN = false;
    const float* base; float* out; int ldc; const float* gate; int gpitch; int rows_per_batch;
    __device__ __forceinline__ void operator()(const f32x4 (&acc)[2][2][4][2], const Unit& u, int wr, int wc, int fr, int fq) const {
        const int col0 = u.pn * BM + wc * 32 + 4 * fq; const int b = (u.pm * BM) / rows_per_batch;
        f32x4 gv[2][2];
#pragma unroll
        for (int bj = 0; bj < 2; ++bj)
#pragma unroll
            for (int n = 0; n < 2; ++n) gv[bj][n] = *(const f32x4*)(gate + (size_t)b * gpitch + col0 + bj * HALF + n * 16);
#pragma unroll
        for (int ai = 0; ai < 2; ++ai)
#pragma unroll
            for (int m = 0; m < 4; ++m) { const size_t off = (size_t)(u.pm * BM + ai * HALF + wr * 64 + m * 16 + fr) * ldc + col0;
#pragma unroll
                for (int bj = 0; bj < 2; ++bj)
#pragma unroll
                    for (int n = 0; n < 2; ++n) { const f32x4 bs = *(const f32x4*)(base + off + bj * HALF + n * 16);
                        *(f32x4*)(out + off + bj * HALF + n * 16) = bs + gv[bj][n] * acc[ai][bj][m][n]; }
                if (m & 1) asm volatile("" ::: "memory"); }
    }
};
template <class Epi, class Sched, bool ALIGN_EPI = false, bool SP2 = false>
__device__ __forceinline__ void gemm_phase(PG8_LAS unsigned char* lds, const Gemm g, const Sched& S, const Epi& E) {
    int tid_ = threadIdx.x; asm volatile("" : "+v"(tid_));
    const int tid = tid_, wid = __builtin_amdgcn_readfirstlane(tid >> 6), lane = tid & 63, wr = wid >> 2, wc = wid & 3, fr = lane & 15, fq = lane >> 4;
    const int K = g.K, nt = K / BK;
    unsigned voffA[2], voffB[2];
#pragma unroll
    for (int i = 0; i < 2; ++i) { int R, C; stage_rc(tid * 16 + i * 8192, R, C); const int Rb = Epi::PERM ? ((R & ~31) + perm32(R & 31)) : R;
        voffA[i] = (unsigned)(R * K + C) * 2u; voffB[i] = (unsigned)(Rb * K + C) * 2u; }
    const size_t kstep = (size_t)(BK * 2);
    const size_t hstep = (size_t)HALF * K * 2;
    const size_t tstep = 2 * hstep;
    const unsigned ldsw = (unsigned)wid * 1024u;
    const int aoff = lds_byte(wr * 64 + fr, fq * 8), boff = lds_byte(wc * 32 + fr, fq * 8);
#define PG8_SA(b, h) (((b) * 2 + (h)) * HTB)
#define PG8_SB(b, h) ((4 + (b) * 2 + (h)) * HTB)
#define PG8_STAGE(bufoff, gbase, voff) do { _Pragma("unroll") for (int _i = 0; _i < 2; ++_i) \
        __builtin_amdgcn_global_load_lds((const unsigned*)((const char*)(gbase) + (voff)[_i]), (PG8_LAS unsigned*)(lds + (bufoff) + ldsw + _i * 8192), 16, 0, 0); } while (0)
#define PG8_LDA(dst, b, h) do { _Pragma("unroll") for (int m = 0; m < 4; ++m) _Pragma("unroll") for (int k = 0; k < 2; ++k) dst[m][k] = *(const PG8_LAS bf16x8*)(lds + PG8_SA(b, h) + aoff + m * 2048 + k * 1024); } while (0)
#define PG8_LDB(dst, b, h) do { _Pragma("unroll") for (int n = 0; n < 2; ++n) _Pragma("unroll") for (int k = 0; k < 2; ++k) dst[n][k] = *(const PG8_LAS bf16x8*)(lds + PG8_SB(b, h) + boff + n * 2048 + k * 1024); } while (0)
#define PG8_MMA(ai, bj, At, Bt) do { __builtin_amdgcn_s_setprio(1); _Pragma("unroll") for (int m = 0; m < 4; ++m) _Pragma("unroll") for (int n = 0; n < 2; ++n) _Pragma("unroll") for (int k = 0; k < 2; ++k) \
        acc[ai][bj][m][n] = __builtin_amdgcn_mfma_f32_16x16x32_bf16(Bt[n][k], At[m][k], acc[ai][bj][m][n], 0, 0, 0); __builtin_amdgcn_s_setprio(0); } while (0)
#define PG8_WAIT_V(n) asm volatile("s_waitcnt vmcnt(" #n ")" ::: "memory")
#define PG8_WAIT_L(n) asm volatile("s_waitcnt lgkmcnt(" #n ")" ::: "memory")
#define PG8_BAR __builtin_amdgcn_s_barrier()
#define PG8_SCHED __builtin_amdgcn_sched_barrier(0)
    Unit cur, nxt; int ui = 0;
    if (!S.next(0, cur)) return;
    f32x4 acc[2][2][4][2];
#pragma unroll
    for (int a = 0; a < 2; ++a)
#pragma unroll
        for (int b = 0; b < 2; ++b)
#pragma unroll
            for (int m = 0; m < 4; ++m)
#pragma unroll
                for (int n = 0; n < 2; ++n) acc[a][b][m][n] = (f32x4){0.f, 0.f, 0.f, 0.f};
    bf16x8 At[4][2], B0[2][2], B1[2][2];
    const char* cA = (const char*)g.A + (size_t)cur.pm * tstep; const char* cB = (const char*)g.Bt + (size_t)cur.pn * tstep;
    S.a_ready(cur);
    if constexpr (SP2) {
        PG8_STAGE(PG8_SB(0, 0), cB, voffB); PG8_STAGE(PG8_SB(0, 1), cB + hstep, voffB); PG8_STAGE(PG8_SA(0, 0), cA, voffA); PG8_STAGE(PG8_SA(0, 1), cA + hstep, voffA);
        if (wr == 1) PG8_BAR;
        PG8_WAIT_V(2); PG8_BAR;
        PG8_STAGE(PG8_SB(1, 0), cB + kstep, voffB); PG8_STAGE(PG8_SA(1, 0), cA + kstep, voffA); PG8_STAGE(PG8_SB(1, 1), cB + hstep + kstep, voffB);
        PG8_WAIT_V(6); PG8_BAR;
    } else {
        PG8_STAGE(PG8_SB(0, 0), cB, voffB); PG8_STAGE(PG8_SA(0, 0), cA, voffA); PG8_STAGE(PG8_SB(0, 1), cB + hstep, voffB); PG8_STAGE(PG8_SA(0, 1), cA + hstep, voffA);
        if (wr == 1) PG8_BAR;
        PG8_WAIT_V(4); PG8_BAR;
        PG8_STAGE(PG8_SB(1, 0), cB + kstep, voffB); PG8_STAGE(PG8_SA(1, 0), cA + kstep, voffA); PG8_STAGE(PG8_SB(1, 1), cB + hstep + kstep, voffB);
        PG8_WAIT_V(6); PG8_BAR;
    }
    for (;;) {
        const bool has_next = S.next(ui + 1, nxt);
        const char* nA = has_next ? (const char*)g.A + (size_t)nxt.pm * tstep : cA; const char* nB = has_next ? (const char*)g.Bt + (size_t)nxt.pn * tstep : cB;
        for (int t = 0; t < nt; t += 2) {
            const bool last = (t == nt - 2);
            const char* a1 = cA + (size_t)(t + 1) * kstep;
            const char* a2 = last ? nA : cA + (size_t)(t + 2) * kstep; const char* b2 = last ? nB : cB + (size_t)(t + 2) * kstep;
            const char* a3 = a2 + kstep; const char* b3 = b2 + kstep;
            if (last && has_next) S.a_ready(nxt);
            if constexpr (SP2) {
            PG8_LDB(B0, 0, 0); PG8_LDB(B1, 0, 1); PG8_SCHED; PG8_LDA(At, 0, 0); PG8_STAGE(PG8_SA(1, 1), a1 + hstep, voffA);
            PG8_WAIT_V(8); PG8_WAIT_L(0); PG8_BAR; PG8_MMA(0, 0, At, B0); PG8_MMA(0, 1, At, B1); PG8_BAR; PG8_SCHED;
            PG8_LDA(At, 0, 1); PG8_STAGE(PG8_SB(0, 0), b2, voffB); PG8_STAGE(PG8_SB(0, 1), b2 + hstep, voffB); PG8_STAGE(PG8_SA(0, 0), a2, voffA);
            PG8_WAIT_V(8); PG8_WAIT_L(0); PG8_BAR; PG8_MMA(1, 0, At, B0); PG8_MMA(1, 1, At, B1); PG8_BAR; PG8_SCHED;
            PG8_LDB(B0, 1, 0); PG8_LDB(B1, 1, 1); PG8_SCHED; PG8_LDA(At, 1, 0); PG8_STAGE(PG8_SA(0, 1), a2 + hstep, voffA);
            PG8_WAIT_V(8); PG8_WAIT_L(0); PG8_BAR; PG8_MMA(0, 0, At, B0); PG8_MMA(0, 1, At, B1); PG8_BAR; PG8_SCHED;
            PG8_LDA(At, 1, 1); PG8_STAGE(PG8_SB(1, 0), b3, voffB); PG8_STAGE(PG8_SB(1, 1), b3 + hstep, voffB); PG8_STAGE(PG8_SA(1, 0), a3, voffA);
            PG8_WAIT_V(8); PG8_WAIT_L(0); PG8_BAR; PG8_MMA(1, 0, At, B0); PG8_MMA(1, 1, At, B1); PG8_BAR; PG8_SCHED;
            } else {
            PG8_LDB(B0, 0, 0); PG8_SCHED; PG8_LDA(At, 0, 0); PG8_STAGE(PG8_SA(1, 1), a1 + hstep, voffA);
            PG8_WAIT_L(8); PG8_BAR; PG8_WAIT_L(0); PG8_MMA(0, 0, At, B0); PG8_BAR; PG8_SCHED;
            PG8_LDB(B1, 0, 1); PG8_STAGE(PG8_SB(0, 0), b2, voffB);
            PG8_BAR; PG8_WAIT_L(0); PG8_MMA(0, 1, At, B1); PG8_BAR;
            PG8_LDA(At, 0, 1); PG8_STAGE(PG8_SA(0, 0), a2, voffA);
            PG8_BAR; PG8_WAIT_L(0); PG8_MMA(1, 0, At, B0); PG8_BAR; PG8_SCHED;
            PG8_STAGE(PG8_SB(0, 1), b2 + hstep, voffB);
            PG8_WAIT_V(6); PG8_BAR; PG8_MMA(1, 1, At, B1); PG8_BAR;
            PG8_LDB(B0, 1, 0); PG8_SCHED; PG8_LDA(At, 1, 0); PG8_STAGE(PG8_SA(0, 1), a2 + hstep, voffA);
            PG8_WAIT_L(8); PG8_BAR; PG8_WAIT_L(0); PG8_MMA(0, 0, At, B0); PG8_BAR; PG8_SCHED;
            PG8_LDB(B1, 1, 1); PG8_STAGE(PG8_SB(1, 0), b3, voffB);
            PG8_BAR; PG8_WAIT_L(0); PG8_MMA(0, 1, At, B1); PG8_BAR;
            PG8_LDA(At, 1, 1); PG8_STAGE(PG8_SA(1, 0), a3, voffA);
            PG8_BAR; PG8_WAIT_L(0); PG8_MMA(1, 0, At, B0); PG8_BAR; PG8_SCHED;
            PG8_STAGE(PG8_SB(1, 1), b3 + hstep, voffB);
            PG8_WAIT_V(6); PG8_BAR; PG8_MMA(1, 1, At, B1); PG8_BAR;
            }
        }
        if constexpr (ALIGN_EPI) { if (wr == 0) PG8_BAR; }
        if constexpr (!Epi::AFTER_DRAIN) { E(acc, cur, wr, wc, fr, fq); S.done(cur); }
        if (!has_next) break;
#pragma unroll
        for (int a = 0; a < 2; ++a)
#pragma unroll
            for (int b = 0; b < 2; ++b)
#pragma unroll
                for (int m = 0; m < 4; ++m)
#pragma unroll
                    for (int n = 0; n < 2; ++n) acc[a][b][m][n] = (f32x4){0.f, 0.f, 0.f, 0.f};
        cur = nxt; cA = nA; cB = nB; ++ui;
        if constexpr (ALIGN_EPI) { if (wr == 1) PG8_BAR; }
    }
    PG8_WAIT_V(0);
    if constexpr (!ALIGN_EPI) { if (wr == 0) PG8_BAR; }
    PG8_BAR;
    if constexpr (Epi::AFTER_DRAIN) { E.fused(acc, cur, wr, wc, fr, fq, lds, wid, lane); S.done(cur); }
#undef PG8_SA
#undef PG8_SB
#undef PG8_STAGE
#undef PG8_LDA
#undef PG8_LDB
#undef PG8_MMA
#undef PG8_WAIT_V
#undef PG8_WAIT_L
#undef PG8_BAR
#undef PG8_SCHED
}
}
constexpr int NWAVES = 8;
constexpr int NB = 2, SEQ = 4096, DM = 2048, NL = 4, MTOK = NB * SEQ, DIN = 5296, DFF = 8192, MODW = 6 * DM;
constexpr int ZP = 5376;
constexpr int Z_FQ = 0, Z_FK = 768, Z_FV = 1536, Z_NQ = 2304, Z_KC = 3072, Z_VC = 3264, Z_KS = 3456, Z_VS = 3648, Z_KW = 3840, Z_VW = 4032, Z_FF = 4224, Z_NG = 4236, Z_CA = 4352, Z_CG = 4864;
__host__ __device__ constexpr int zsrc(int n) {
    return n < 2304 ? n : n < 3072 ? 2316 + (n - 2304) : n < 4224 ? 3084 + (n - 3072) : n < 4236 ? 2304 + (n - 4224) : n < 4272 ? n : n < 4352 ? -1 : 4272 + (n - 4352);
}
constexpr unsigned Z_QTILES = 0xE07u;
constexpr float LOG2E = 1.4426950408889634f;
constexpr float QSCALE = 0.125f * LOG2E;
constexpr float RMS_EPS = 1e-6f;
constexpr int PH_PRO = 0, PH_FIN = 1, PH_L0 = 2, PH_PER_LAYER = 8, PH_FINAL = PH_L0 + NL * PH_PER_LAYER, NPH = PH_FINAL + 1;
enum { LP_NORM1 = 0, LP_GIN = 1, LP_PRE = 2, LP_ATTN = 3, LP_GOUT = 4, LP_NORM2 = 5, LP_G1 = 6, LP_G2 = 7 };
constexpr size_t MiB = 1u << 20;
constexpr size_t WS_CTL = 0, CTL_ZERO_BYTES = 1 * MiB;
constexpr size_t WS_WIN = 1 * MiB, WS_WOUT = 85 * MiB, WS_W1 = 117 * MiB, WS_W2 = 245 * MiB;
constexpr size_t WS_MODP = 373 * MiB, WS_MOD = 379 * MiB, WS_LUT = 380 * MiB, WS_WCT = 381 * MiB;
constexpr size_t WS_X = 384 * MiB, WS_XN = 448 * MiB, WS_Z = 480 * MiB, WS_MIX = 564 * MiB, WS_HB = 596 * MiB;
constexpr size_t WS_F2 = 724 * MiB, WS_KCMP = 725 * MiB, WS_VCMP = 725 * MiB + 256 * 1024;
constexpr size_t WS_DBG = 728 * MiB;
constexpr size_t WS_END = 760 * MiB;
static_assert((size_t)NL * ZP * DM * 2 == 84 * MiB && (size_t)MTOK * ZP * 2 == 84 * MiB && (size_t)MTOK * DFF * 2 == 128 * MiB, "ws map");
constexpr int MOD_KCH = 16;
constexpr int CW_TMO = 0, CW_CODE = 1, CW_BAR = 4096, CW_Q = 8192;
constexpr int RING_OFF = 0, RING_BYTES = 131072, LDSCTL_OFF = RING_BYTES, MISC_OFF = LDSCTL_OFF + 320, LDS_BYTES = 147456;

#define GAS __attribute__((address_space(1)))
#define LAS __attribute__((address_space(3)))
typedef unsigned short bf16;
typedef unsigned v4u __attribute__((ext_vector_type(4)));
typedef unsigned v2u __attribute__((ext_vector_type(2)));
typedef float f32x4 __attribute__((ext_vector_type(4)));
typedef float f32x16 __attribute__((ext_vector_type(16)));
typedef short bf16x8 __attribute__((ext_vector_type(8)));
typedef short s16x4 __attribute__((ext_vector_type(4)));
typedef GAS unsigned gu32;
#define RLX_AGENT __ATOMIC_RELAXED, __HIP_MEMORY_SCOPE_AGENT
#define LDS_WAIT() asm volatile("s_waitcnt lgkmcnt(0)" ::: "memory")
#define VM_WAIT() asm volatile("s_waitcnt vmcnt(0)" ::: "memory")
__device__ __forceinline__ unsigned pk2(float lo, float hi) { unsigned r; asm volatile("v_cvt_pk_bf16_f32 %0, %1, %2" : "=v"(r) : "v"(lo), "v"(hi)); return r; }
__device__ __forceinline__ float bf_lo(unsigned w) { return __uint_as_float(w << 16); }
__device__ __forceinline__ float bf_hi(unsigned w) { return __uint_as_float(w & 0xffff0000u); }
__device__ __forceinline__ float bf1(bf16 h) { return __uint_as_float((unsigned)h << 16); }
__device__ __forceinline__ float sigm(float x) { return 1.f / (1.f + __expf(-x)); }
__device__ __forceinline__ float wave_sum(float v) {
#pragma unroll
    for (int o = 1; o < 64; o <<= 1) v += __shfl_xor(v, o);
    return v;
}
__device__ __forceinline__ int t5_bucket(int dist) {
    int n = dist > 0 ? dist : 0;
    if (n < 16) return n;
    int large = 16 + (int)(logf((float)n / 16.0f) / 2.0794415416798357f * 16.0f);
    return large < 31 ? large : 31;
}
#define XB_TMO      128
#define XB_XCNT(j)  (256  + 64 * (j))
#define XB_XSUB(j)  (1280 + 64 * (j))
#define XB_XGEN(j)  (2304 + 64 * (j))
#define XB_TOP      3328
#define XB_TOPGEN   3392
#define XCD_BAR_WORDS 3456
#define XB_SPIN_CAP (1u << 18)

__device__ __forceinline__ unsigned xb_ld(unsigned* p)              { return __hip_atomic_load(p, __ATOMIC_RELAXED, __HIP_MEMORY_SCOPE_AGENT); }
__device__ __forceinline__ unsigned xb_add(unsigned* p, unsigned v) { return __hip_atomic_fetch_add(p, v, __ATOMIC_RELAXED, __HIP_MEMORY_SCOPE_AGENT); }
__device__ __forceinline__ unsigned xb_xcc_id() { return (unsigned)__builtin_amdgcn_s_getreg((3 << 11) | 20) & 0xFu; }
#define XB_SPIN(cond, bar) do { unsigned _sp = 0; while (cond) { __builtin_amdgcn_s_sleep(1); \
    if ((++_sp & 255u) == 0u) { if (xb_ld(&(bar)[XB_TMO])) break; if (_sp > XB_SPIN_CAP) { atomicAdd(&(bar)[XB_TMO], 1u); break; } } } } while (0)

struct XcdBarrier {
    unsigned* bar; unsigned x;
    volatile LAS unsigned* st;
};

__device__ __forceinline__ XcdBarrier xcd_barrier_post(unsigned* bar, volatile LAS unsigned* st) {
    XcdBarrier b; b.bar = bar; b.x = xb_xcc_id(); b.st = st;
    if (threadIdx.x == 0) (void)xb_add(&bar[XB_XCNT(b.x)], 1u);
    return b;
}
__device__ __forceinline__ void xcd_barrier_complete(unsigned* bar, unsigned x, unsigned& nloc, unsigned& nx) {
    const unsigned G = gridDim.x * gridDim.y * gridDim.z;
    unsigned sum, cnt, mine, sp = 0u;
    for (;;) {
        sum = 0u; cnt = 0u; mine = 0u;
#pragma unroll
        for (unsigned j = 0; j < 16; ++j) { const unsigned c = xb_ld(&bar[XB_XCNT(j)]); sum += c; cnt += (c > 0u) ? 1u : 0u; mine = (j == x) ? c : mine; }
        if (sum == G) break;
        __builtin_amdgcn_s_sleep(1);
        if ((++sp & 255u) == 0u) { if (xb_ld(&bar[XB_TMO])) break; if (sp > XB_SPIN_CAP) { atomicAdd(&bar[XB_TMO], 1u); break; } }
    }
    nloc = mine > 0u ? mine : 1u; nx = cnt > 0u ? cnt : 1u;
}

__device__ __forceinline__ void xcd_barrier(const XcdBarrier& b) {
    asm volatile("s_waitcnt vmcnt(0)" ::: "memory");
    __syncthreads();
    if (threadIdx.x == 0) {
        unsigned* bar = b.bar; unsigned bx_ = b.x;
        asm volatile("" : "+s"(bar), "+s"(bx_));
        __builtin_amdgcn_s_waitcnt(0);
        unsigned nloc = b.st[0], nx = b.st[1];
        if (nloc == 0u) { xcd_barrier_complete(bar, bx_, nloc, nx); b.st[0] = nloc; b.st[1] = nx; }
        const unsigned old = xb_add(&bar[XB_XSUB(bx_)], 1u);
        const unsigned gen = old / nloc;
        if (old + 1u == (gen + 1u) * nloc) {
            __builtin_amdgcn_fence(__ATOMIC_RELEASE, "agent");
            asm volatile("s_waitcnt vmcnt(0)" ::: "memory");
            const unsigned og = xb_add(&bar[XB_TOP], 1u);
            const unsigned tg = og / nx;
            if (og + 1u == (tg + 1u) * nx) xb_add(&bar[XB_TOPGEN], 1u);
            else XB_SPIN(xb_ld(&bar[XB_TOPGEN]) == tg, bar);
            __builtin_amdgcn_fence(__ATOMIC_ACQUIRE, "agent");
            xb_add(&bar[XB_XGEN(bx_)], 1u);
            asm volatile("s_waitcnt vmcnt(0)" ::: "memory");
        } else {
            XB_SPIN(xb_ld(&bar[XB_XGEN(bx_)]) == gen, bar);
            __builtin_amdgcn_fence(__ATOMIC_ACQUIRE, "agent");
            asm volatile("s_waitcnt vmcnt(0)" ::: "memory");
        }
    }
    __syncthreads();
}
struct Frame {
    LAS unsigned char* lds;
    volatile LAS unsigned* MISC;
    gu32* ctl;
    int tid, lane, wave, gw, ngw;
    unsigned char* ws;
};
struct Args { const float* in[20]; float* out; unsigned char* ws; int ph_lo, ph_hi, flags, pad; };
typedef const __attribute__((address_space(4))) Args* KA;
__device__ __forceinline__ KA kargs() { KA p = (KA)__builtin_amdgcn_kernarg_segment_ptr(); asm volatile("" : "+s"(p)); return p; }
enum { IN_X = 0, IN_C, IN_WMOD, IN_BMOD, IN_N1G, IN_WIN, IN_BF, IN_WCK, IN_WCV, IN_POS, IN_CW, IN_CB, IN_CLG, IN_CLB, IN_WOUT, IN_N2G, IN_W1, IN_W2, IN_RELB, IN_FING };
enum { FL_FOX = 1, FL_NSA = 2, FL_PRE = 4 };

template <bool PERM> __device__ __forceinline__ void tr_item(const float* W, int K, int N, bf16* WT, LAS float* scr, int kb, int nb, int lane) {
    const int k0 = 64 * kb, n0 = 32 * nb; const int nd = n0 + (lane & 31); const int sc = PERM ? zsrc(nd) : nd;
    const float* src = W + (size_t)(k0 + (lane >> 5)) * N + (sc >= 0 ? sc : 0);
    float v[32];
#pragma unroll
    for (int i = 0; i < 32; ++i) v[i] = src[(size_t)(2 * i) * N];
#pragma unroll
    for (int i = 0; i < 32; ++i) scr[(2 * i + (lane >> 5)) * 33 + (lane & 31)] = sc >= 0 ? v[i] : 0.f;
    LDS_WAIT(); asm volatile("" ::: "memory");
    const int c = lane & 7;
#pragma unroll
    for (int j = 0; j < 4; ++j) { const int n = (lane >> 3) + 8 * j; const LAS float* s = scr + (8 * c) * 33 + n;
        v4u o; o.x = pk2(s[0 * 33], s[1 * 33]); o.y = pk2(s[2 * 33], s[3 * 33]); o.z = pk2(s[4 * 33], s[5 * 33]); o.w = pk2(s[6 * 33], s[7 * 33]);
        *(GAS v4u*)(WT + (size_t)(n0 + n) * K + k0 + 8 * c) = o; }
    LDS_WAIT(); asm volatile("" ::: "memory");
}
constexpr int IT_MOD = NL * 48 * MOD_KCH;
constexpr int IT_TIN = (DM / 64) * (ZP / 32), IT_TOUT = (DM / 64) * (DM / 32), IT_T1 = (DM / 64) * (DFF / 32), IT_T2 = (DFF / 64) * (DM / 32), IT_TL = IT_TIN + IT_TOUT + IT_T1 + IT_T2;
constexpr int IT_WCT = NL * 2 * 32, IT_TOTAL = IT_MOD + NL * IT_TL + IT_WCT + 1;
constexpr int PRO_CACT_OFF = 8 * 8448;

__device__ __forceinline__ void p_prologue(Frame& F, KA A) {
    LAS float* scr = (LAS float*)(F.lds + RING_OFF + F.wave * 8448);
    LAS float* cact = (LAS float*)(F.lds + RING_OFF + PRO_CACT_OFF);
    for (int i = F.tid; i < 2 * DM; i += NWAVES * 64) { const float v = A->in[IN_C][i]; cact[i] = v * sigm(v); }
    LDS_WAIT(); __syncthreads();
    bf16* WIN = (bf16*)(F.ws + WS_WIN); bf16* WOUT = (bf16*)(F.ws + WS_WOUT); bf16* W1 = (bf16*)(F.ws + WS_W1); bf16* W2 = (bf16*)(F.ws + WS_W2);
    float* MODP = (float*)(F.ws + WS_MODP);
    for (int it = F.gw; it < IT_TOTAL; it += F.ngw) {
        int r = it;
        if (r < IT_MOD) {
            const int kc = r % MOD_KCH, cg = (r / MOD_KCH) % 48, l = r / (MOD_KCH * 48); constexpr int KCL = DM / MOD_KCH;
            const float* w = A->in[IN_WMOD] + ((size_t)l * DM + KCL * kc) * MODW + 256 * cg + 4 * F.lane;
            f32x4 a0 = {0.f, 0.f, 0.f, 0.f}, a1 = {0.f, 0.f, 0.f, 0.f};
#pragma unroll 16
            for (int k = 0; k < KCL; ++k) { const f32x4 wv = *(const GAS f32x4*)(w + (size_t)k * MODW); a0 += wv * cact[KCL * kc + k]; a1 += wv * cact[DM + KCL * kc + k]; }
            *(GAS f32x4*)(MODP + ((size_t)(kc * NL + l) * 2 + 0) * MODW + 256 * cg + 4 * F.lane) = a0;
            *(GAS f32x4*)(MODP + ((size_t)(kc * NL + l) * 2 + 1) * MODW + 256 * cg + 4 * F.lane) = a1;
            continue; }
        r -= IT_MOD;
        if (r < NL * IT_TL) { const int l = r / IT_TL; r %= IT_TL;
            if (r < IT_TIN) { tr_item<true>(A->in[IN_WIN] + (size_t)l * DM * DIN, DM, DIN, WIN + (size_t)l * ZP * DM, scr, r / (ZP / 32), r % (ZP / 32), F.lane); continue; } r -= IT_TIN;
            if (r < IT_TOUT) { tr_item<false>(A->in[IN_WOUT] + (size_t)l * DM * DM, DM, DM, WOUT + (size_t)l * DM * DM, scr, r / (DM / 32), r % (DM / 32), F.lane); continue; } r -= IT_TOUT;
            if (r < IT_T1) { tr_item<false>(A->in[IN_W1] + (size_t)l * DM * DFF, DM, DFF, W1 + (size_t)l * DFF * DM, scr, r / (DFF / 32), r % (DFF / 32), F.lane); continue; } r -= IT_T1;
            tr_item<false>(A->in[IN_W2] + (size_t)l * DFF * DM, DFF, DM, W2 + (size_t)l * DM * DFF, scr, r / (DM / 32), r % (DM / 32), F.lane); continue; }
        r -= NL * IT_TL;
        if (r < IT_WCT) {
            const int lp = r % 32, kv = (r / 32) & 1, l = r / 64;
            const float* w = A->in[kv ? IN_WCV : IN_WCK] + ((size_t)(l * 32 + lp) * 64) * 64 + F.lane;
            bf16* o = (bf16*)(F.ws + WS_WCT) + ((size_t)((l * 2 + kv) * 32 + lp) * 64 + F.lane) * 64;
#pragma unroll
            for (int d8 = 0; d8 < 8; ++d8) { float x[8];
#pragma unroll
                for (int i = 0; i < 8; ++i) x[i] = w[(size_t)(8 * d8 + i) * 64];
                v4u q; q.x = pk2(x[0], x[1]); q.y = pk2(x[2], x[3]); q.z = pk2(x[4], x[5]); q.w = pk2(x[6], x[7]);
                *(GAS v4u*)(o + 8 * d8) = q; }
            continue; }
        {
            float* LUT = (float*)(F.ws + WS_LUT);
            for (int i = F.lane; i < 12 * 128; i += 64) { const int h = i / 128, d = i % 128; LUT[i] = A->in[IN_RELB][t5_bucket(d) * 12 + h] * LOG2E; }
        }
    }
}
__device__ __forceinline__ void p_modfin(Frame& F, KA A) {
    const float* MODP = (const float*)(F.ws + WS_MODP); float* MOD = (float*)(F.ws + WS_MOD);
    for (int i = F.gw * 64 + F.lane; i < NL * 2 * MODW; i += F.ngw * 64) { const int j = i % MODW, l = i / (2 * MODW);
        float s = A->in[IN_BMOD][l * MODW + j];
#pragma unroll
        for (int kc = 0; kc < MOD_KCH; ++kc) s += MODP[(size_t)kc * NL * 2 * MODW + i];
        MOD[i] = s; }
}
__device__ __forceinline__ void p_norm(Frame& F, const float* xin, const float* gain, const float* modl, int sh_off, int sc_off, bf16* XN) {
    for (int row = F.gw; row < MTOK; row += F.ngw) { const int b = row / SEQ;
        const GAS f32x4* xr = (const GAS f32x4*)(xin + (size_t)row * DM) + F.lane;
        f32x4 v[8]; float ss = 0.f;
#pragma unroll
        for (int j = 0; j < 8; ++j) { v[j] = xr[64 * j]; ss += (v[j].x * v[j].x + v[j].y * v[j].y) + (v[j].z * v[j].z + v[j].w * v[j].w); }
        const float rs = rsqrtf(wave_sum(ss) * (1.f / DM) + RMS_EPS);
        const float* mb = modl + (size_t)b * MODW;
        GAS v2u* o8 = (GAS v2u*)(XN + (size_t)row * DM) + F.lane;
#pragma unroll
        for (int j = 0; j < 8; ++j) { const int col = 4 * (F.lane + 64 * j);
            const f32x4 g4 = *(const GAS f32x4*)(gain + col), sc4 = *(const GAS f32x4*)(mb + sc_off + col), sh4 = *(const GAS f32x4*)(mb + sh_off + col);
            const f32x4 y = v[j] * rs * g4 * (sc4 + 1.f) + sh4;
            v2u w; w.x = pk2(y.x, y.y); w.y = pk2(y.z, y.w); o8[64 * j] = w; }
    }
}
__device__ __forceinline__ void p_final(Frame& F, const float* xin, const float* gain, float* out) {
    for (int row = F.gw; row < MTOK; row += F.ngw) {
        const GAS f32x4* xr = (const GAS f32x4*)(xin + (size_t)row * DM) + F.lane;
        f32x4 v[8]; float ss = 0.f;
#pragma unroll
        for (int j = 0; j < 8; ++j) { v[j] = xr[64 * j]; ss += (v[j].x * v[j].x + v[j].y * v[j].y) + (v[j].z * v[j].z + v[j].w * v[j].w); }
        const float rs = rsqrtf(wave_sum(ss) * (1.f / DM) + RMS_EPS);
        GAS f32x4* o = (GAS f32x4*)(out + (size_t)row * DM) + F.lane;
#pragma unroll
        for (int j = 0; j < 8; ++j) { const f32x4 g4 = *(const GAS f32x4*)(gain + 4 * (F.lane + 64 * j)); o[64 * j] = v[j] * rs * g4; }
    }
}
__device__ __forceinline__ void pre_compress_unit(Frame& F, KA A, int l, int u) {
    const int kv = u & 1, mt = (u >> 1) & 7, bg = u >> 4, b = bg / 3, g = bg % 3;
    const int w = F.wave, nb = w & 1, part = (w >> 1) & 1, kh = w >> 2, m = F.lane & 31, hi = F.lane >> 5;
    const int mb = 32 * mt + m + part;
    const bf16* Z = (const bf16*)(F.ws + WS_Z);
    const bf16* zp = Z + (size_t)(b * SEQ + 16 * (mb < 256 ? mb : 0)) * ZP + (kv ? Z_VC : Z_KC) + g * 64 + 8 * hi;
    const float* posp = A->in[IN_POS] + (size_t)l * 32 * 64 + (16 * part) * 64 + 8 * hi;
    const bf16* wt = (const bf16*)(F.ws + WS_WCT) + ((size_t)((l * 2 + kv) * 32 + 16 * part) * 64 + 32 * nb + m) * 64 + 8 * hi;
    f32x16 acc = {};
    for (int ll = 8 * kh; ll < 8 * kh + 8; ++ll) {
#pragma unroll
        for (int d0 = 0; d0 < 64; d0 += 16) {
            v4u az = *(const GAS v4u*)(zp + (size_t)ll * ZP + d0); if (mb >= 256) az = (v4u){0u, 0u, 0u, 0u};
            const f32x4 p0 = *(const GAS f32x4*)(posp + ll * 64 + d0), p1 = *(const GAS f32x4*)(posp + ll * 64 + d0 + 4);
            v4u aw; aw.x = pk2(bf_lo(az.x) + p0.x, bf_hi(az.x) + p0.y); aw.y = pk2(bf_lo(az.y) + p0.z, bf_hi(az.y) + p0.w);
            aw.z = pk2(bf_lo(az.z) + p1.x, bf_hi(az.z) + p1.y); aw.w = pk2(bf_lo(az.w) + p1.z, bf_hi(az.w) + p1.w);
            const v4u bw = *(const GAS v4u*)(wt + (size_t)ll * 64 * 64 + d0);
            acc = __builtin_amdgcn_mfma_f32_32x32x16_bf16(__builtin_bit_cast(bf16x8, aw), __builtin_bit_cast(bf16x8, bw), acc, 0, 0, 0);
        }
    }
    LAS float* red = (LAS float*)(F.lds + RING_OFF);
#pragma unroll
    for (int r = 0; r < 16; ++r) { const int mloc = (r & 3) + 8 * (r >> 2) + 4 * hi; red[w * 1024 + mloc * 32 + m] = acc[r]; }
    LDS_WAIT(); __syncthreads();
    { const int mloc = F.tid >> 4, e4 = (F.tid & 15) * 4, nb2 = e4 >> 5, el = e4 & 31;
      f32x4 s = {0.f, 0.f, 0.f, 0.f};
#pragma unroll
      for (int q = 0; q < 4; ++q) s += *(const LAS f32x4*)(red + (nb2 + 2 * q) * 1024 + mloc * 32 + el);
      bf16* dst = (bf16*)(F.ws + (kv ? WS_VCMP : WS_KCMP)) + ((size_t)(b * 3 + g) * 256 + 32 * mt + mloc) * 64 + e4;
      v2u o; o.x = pk2(s.x, s.y); o.y = pk2(s.z, s.w); *(GAS v2u*)dst = o; }
    LDS_WAIT(); __syncthreads();
}
__device__ __forceinline__ float logsig(float x) { return x >= 0.f ? -log1pf(expf(-x)) : x - log1pf(expf(x)); }
__device__ __forceinline__ void pre_cumsum(Frame& F, KA A, int l, int b) {
    const bf16* Z = (const bf16*)(F.ws + WS_Z); float* NF2 = (float*)(F.ws + WS_F2);
    const float* bfp = A->in[IN_BF] + l * 12;
    float bfv[12], run[12];
#pragma unroll
    for (int h = 0; h < 12; ++h) { bfv[h] = bfp[h]; run[h] = 0.f; }
    const int t0 = F.tid * 8;
    for (int i = 0; i < 8; ++i) { const GAS v2u* p = (const GAS v2u*)(Z + (size_t)(b * SEQ + t0 + i) * ZP + Z_FF); const v2u a = p[0], c = p[1], d = p[2];
        const unsigned wv[6] = {a.x, a.y, c.x, c.y, d.x, d.y};
#pragma unroll
        for (int h2 = 0; h2 < 6; ++h2) { run[2 * h2] += logsig(bf_lo(wv[h2]) + bfv[2 * h2]); run[2 * h2 + 1] += logsig(bf_hi(wv[h2]) + bfv[2 * h2 + 1]); } }
    LAS float* wt = (LAS float*)(F.lds + RING_OFF + 40960);
    float off[12];
#pragma unroll
    for (int h = 0; h < 12; ++h) { float v = run[h];
#pragma unroll
        for (int o = 1; o < 64; o <<= 1) { const float n = __shfl_up(v, o); if (F.lane >= o) v += n; }
        if (F.lane == 63) wt[F.wave * 12 + h] = v;
        off[h] = v - run[h]; }
    LDS_WAIT(); __syncthreads();
#pragma unroll
    for (int h = 0; h < 12; ++h) { float s = 0.f; for (int w2 = 0; w2 < F.wave; ++w2) s += wt[w2 * 12 + h]; off[h] += s; }
    for (int i = 0; i < 8; ++i) { const GAS v2u* p = (const GAS v2u*)(Z + (size_t)(b * SEQ + t0 + i) * ZP + Z_FF); const v2u a = p[0], c = p[1], d = p[2];
        const unsigned wv[6] = {a.x, a.y, c.x, c.y, d.x, d.y};
#pragma unroll
        for (int h2 = 0; h2 < 6; ++h2) { off[2 * h2] += logsig(bf_lo(wv[h2]) + bfv[2 * h2]); off[2 * h2 + 1] += logsig(bf_hi(wv[h2]) + bfv[2 * h2 + 1]);
            NF2[(size_t)(b * 12 + 2 * h2) * SEQ + t0 + i] = -LOG2E * off[2 * h2]; NF2[(size_t)(b * 12 + 2 * h2 + 1) * SEQ + t0 + i] = -LOG2E * off[2 * h2 + 1]; } }
    LDS_WAIT(); __syncthreads();
}
constexpr int CONV_W_OFF = 49152, CONV_TOK = 4;
__device__ __forceinline__ void pre_conv(Frame& F, KA A, int l) {
    const bf16* Z = (const bf16*)(F.ws + WS_Z); bf16* MIX = (bf16*)(F.ws + WS_MIX);
    LAS float* cw = (LAS float*)(F.lds + RING_OFF + CONV_W_OFF);
    { const float* src = A->in[IN_CW] + (size_t)l * 31 * 512; for (int i = F.tid; i < 31 * 512 / 4; i += NWAVES * 64) ((LAS f32x4*)cw)[i] = ((const GAS f32x4*)src)[i]; }
    LDS_WAIT(); __syncthreads();
    const int c0 = 8 * F.lane;
    float cb[8], lg[8], lb[8];
#pragma unroll
    for (int i = 0; i < 8; ++i) { cb[i] = A->in[IN_CB][l * 512 + c0 + i]; lg[i] = A->in[IN_CLG][l * 512 + c0 + i]; lb[i] = A->in[IN_CLB][l * 512 + c0 + i]; }
    for (int it = F.gw; it < MTOK / CONV_TOK; it += F.ngw) {
        const int b = it / (SEQ / CONV_TOK), t1 = (it % (SEQ / CONV_TOK)) * CONV_TOK;
        float acc[CONV_TOK][8];
#pragma unroll
        for (int o = 0; o < CONV_TOK; ++o)
#pragma unroll
            for (int i = 0; i < 8; ++i) acc[o][i] = 0.f;
        for (int tin = (t1 - 30 > 0 ? t1 - 30 : 0); tin < t1 + CONV_TOK; ++tin) {
            const bf16* zr = Z + (size_t)(b * SEQ + tin) * ZP + c0;
            const v4u av = *(const GAS v4u*)(zr + Z_CA), gv = *(const GAS v4u*)(zr + Z_CG);
            float u[8];
            u[0] = bf_lo(av.x) * sigm(bf_lo(gv.x)); u[1] = bf_hi(av.x) * sigm(bf_hi(gv.x)); u[2] = bf_lo(av.y) * sigm(bf_lo(gv.y)); u[3] = bf_hi(av.y) * sigm(bf_hi(gv.y));
            u[4] = bf_lo(av.z) * sigm(bf_lo(gv.z)); u[5] = bf_hi(av.z) * sigm(bf_hi(gv.z)); u[6] = bf_lo(av.w) * sigm(bf_lo(gv.w)); u[7] = bf_hi(av.w) * sigm(bf_hi(gv.w));
#pragma unroll
            for (int o = 0; o < CONV_TOK; ++o) { const int k = tin - (t1 + o) + 30;
                if (k >= 0 && k <= 30) { const f32x4 w0 = *(const LAS f32x4*)(cw + k * 512 + c0), w1 = *(const LAS f32x4*)(cw + k * 512 + c0 + 4);
                    acc[o][0] += w0.x * u[0]; acc[o][1] += w0.y * u[1]; acc[o][2] += w0.z * u[2]; acc[o][3] += w0.w * u[3];
                    acc[o][4] += w1.x * u[4]; acc[o][5] += w1.y * u[5]; acc[o][6] += w1.z * u[6]; acc[o][7] += w1.w * u[7]; } }
        }
#pragma unroll
        for (int o = 0; o < CONV_TOK; ++o) { float s = 0.f;
#pragma unroll
            for (int i = 0; i < 8; ++i) { acc[o][i] += cb[i]; s += acc[o][i]; }
            const float mu = wave_sum(s) * (1.f / 512.f); float q = 0.f;
#pragma unroll
            for (int i = 0; i < 8; ++i) { acc[o][i] -= mu; q += acc[o][i] * acc[o][i]; }
            const float rstd = rsqrtf(wave_sum(q) * (1.f / 512.f) + RMS_EPS);
            float y[8];
#pragma unroll
            for (int i = 0; i < 8; ++i) { const float yn = acc[o][i] * rstd * lg[i] + lb[i]; y[i] = yn * sigm(yn); }
            v4u w; w.x = pk2(y[0], y[1]); w.y = pk2(y[2], y[3]); w.z = pk2(y[4], y[5]); w.w = pk2(y[6], y[7]);
            *(GAS v4u*)(MIX + (size_t)(b * SEQ + t1 + o) * DM + 1536 + c0) = w; }
    }
}
__device__ __forceinline__ void p_pre(Frame& F, KA A, int l) {
    for (int u = blockIdx.x; u < 98; u += gridDim.x) { if (u < 96) pre_compress_unit(F, A, l, u); else pre_cumsum(F, A, l, u - 96); }
    pre_conv(F, A, l);
}
namespace att {
constexpr int SLOTB = 8192;
constexpr int A_K = 0, A_V = 2 * SLOTB, A_WS = 4 * SLOTB, A_OST = A_WS + 2048, A_F = A_OST + 32768, A_IMP = A_F + 16384, A_SEL = A_IMP + 16384, A_LUT = A_SEL + 512,
              A_LINV = A_LUT + 6144, A_IMP2 = A_LINV + 1024, A_Q = A_IMP2 + 64 * 65 * 4, A_END = A_Q + 64;
constexpr int A_IMPRAW = A_OST;
static_assert(A_IMPRAW + 65536 == A_SEL && A_END <= RING_BYTES, "attention LDS map");
enum { MODE_FOX = 0, MODE_SEL = 1, MODE_WIN = 2, MODE_CMPA = 3, MODE_CMPB = 4 };
struct BrP { int tq, ti, lutoff, tdiag; unsigned long long sel; float b31; };
#define ATT_NEG (-INFINITY)
__device__ __forceinline__ int crow(int r, int hi) { return (r & 3) + 8 * (r >> 2) + 4 * hi; }
__device__ __forceinline__ void glds16(const void* gsrc, unsigned lds_dst) { unsigned keep;
    asm volatile("s_mov_b32 %0, m0\n\ts_mov_b32 m0, %2\n\ts_nop 0\n\tglobal_load_lds_dwordx4 %1, off\n\ts_mov_b32 m0, %0" : "=&s"(keep) : "v"(gsrc), "s"(lds_dst) : "memory"); }
#define ATT_WAIT_BAR0() asm volatile("s_waitcnt vmcnt(0) lgkmcnt(0)\n\ts_barrier" ::: "memory")
#define ATT_LBAR() asm volatile("s_waitcnt lgkmcnt(0)\n\ts_barrier" ::: "memory")
__device__ __forceinline__ float xhalf_max(float m) { auto rr = __builtin_amdgcn_permlane32_swap(__float_as_uint(m), __float_as_uint(m), false, false); return fmaxf(__uint_as_float(rr[0]), __uint_as_float(rr[1])); }
__device__ __forceinline__ float xhalf_sum(float m) { auto rr = __builtin_amdgcn_permlane32_swap(__float_as_uint(m), __float_as_uint(m), false, false); return __uint_as_float(rr[0]) + __uint_as_float(rr[1]); }
__device__ __forceinline__ void qkt(f32x16& p0, f32x16& p1, const LAS unsigned char* kb, const bf16x8 (&qr)[4]) {
    const f32x16 z = {};
#pragma unroll
    for (int d0 = 0; d0 < 4; ++d0) {
        const bf16x8 b0 = *(const LAS bf16x8*)(kb + d0 * 2048), b1 = *(const LAS bf16x8*)(kb + d0 * 2048 + 512);
        p0 = __builtin_amdgcn_mfma_f32_32x32x16_bf16(b0, qr[d0], d0 ? p0 : z, 0, 0, 0);
        p1 = __builtin_amdgcn_mfma_f32_32x32x16_bf16(b1, qr[d0], d0 ? p1 : z, 0, 0, 0); }
}
__device__ __forceinline__ void pv(f32x16 (&o)[2], int vb, bf16x8 pa0, bf16x8 pa1, bf16x8 pa2, bf16x8 pa3) {
#pragma unroll
    for (int d0 = 0; d0 < 2; ++d0) { s16x4 lo[4], hi[4];
#pragma unroll
        for (int ks = 0; ks < 4; ++ks) {
            asm volatile("ds_read_b64_tr_b16 %0,%1 offset:%c2" : "=&v"(lo[ks]) : "v"(vb), "i"(d0 * 4096 + ks * 1024) : "memory");
            asm volatile("ds_read_b64_tr_b16 %0,%1 offset:%c2" : "=&v"(hi[ks]) : "v"(vb), "i"(d0 * 4096 + ks * 1024 + 512) : "memory"); }
        asm volatile("s_waitcnt lgkmcnt(0)" ::: "memory"); __builtin_amdgcn_sched_barrier(0);
#define ATT_PK(k) (bf16x8){lo[k][0], lo[k][1], lo[k][2], lo[k][3], hi[k][0], hi[k][1], hi[k][2], hi[k][3]}
        o[d0] = __builtin_amdgcn_mfma_f32_32x32x16_bf16(pa0, ATT_PK(0), o[d0], 0, 0, 0);
        o[d0] = __builtin_amdgcn_mfma_f32_32x32x16_bf16(pa1, ATT_PK(1), o[d0], 0, 0, 0);
        o[d0] = __builtin_amdgcn_mfma_f32_32x32x16_bf16(pa2, ATT_PK(2), o[d0], 0, 0, 0);
        o[d0] = __builtin_amdgcn_mfma_f32_32x32x16_bf16(pa3, ATT_PK(3), o[d0], 0, 0, 0);
#undef ATT_PK
    }
}
__device__ __forceinline__ void o_rowscale(f32x16 (&o)[2], LAS float* wsf, float f, int r32, int hi, bool accumulate, f32x16 (&acc)[2]) {
    if (hi == 0) wsf[r32] = f;
    LDS_WAIT();
#pragma unroll
    for (int a = 0; a < 4; ++a) { const f32x4 s = *(const LAS f32x4*)(wsf + 8 * a + 4 * hi);
#pragma unroll
        for (int i = 0; i < 4; ++i) {
            if (accumulate) { acc[0][4 * a + i] += o[0][4 * a + i] * s[i]; acc[1][4 * a + i] += o[1][4 * a + i] * s[i]; }
            else { o[0][4 * a + i] *= s[i]; o[1][4 * a + i] *= s[i]; } } }
    LDS_WAIT();
}
__device__ __forceinline__ void ot_update(LAS float* otw, f32x16 (&o)[2], LAS float* wsf, float f, int r32, int hi, int mode) {
    if (hi == 0) wsf[r32] = f;
    LDS_WAIT();
#pragma unroll
    for (int a = 0; a < 4; ++a) { const f32x4 s = *(const LAS f32x4*)(wsf + 8 * a + 4 * hi);
#pragma unroll
        for (int i = 0; i < 4; ++i)
#pragma unroll
            for (int d0 = 0; d0 < 2; ++d0) { LAS float* p = otw + (8 * a + 4 * hi + i) * 64 + 32 * d0 + r32; float v = o[d0][4 * a + i] * s[i];
                if (mode) v += *p;
                if (mode < 2) *p = v; else o[d0][4 * a + i] = v; } }
    LDS_WAIT();
}
template <int MODE>
__device__ __forceinline__ void run_branch(LAS unsigned char* lds, const bf16* Kg, const bf16* Vg, int pitch, int tb, int te, const bf16x8 (&qr)[4], f32x16 (&o)[2], float& m, float& l,
                                           const BrP P, int wid, int lane, LAS float* improw, bool want_imp, int tskip) {
    const int r32 = lane & 31, hi = lane >> 5;
    const unsigned lds0 = (unsigned)(uintptr_t)lds;
    const bf16* ksrc = Kg + (size_t)lane * pitch + wid * 8;
    const bf16* vsrc = Vg + (size_t)(16 * (wid & 3) + (lane >> 2)) * pitch + (wid >> 2) * 32 + (lane & 3) * 8;
    const unsigned kdst = lds0 + A_K + wid * 1024, vdst = lds0 + A_V + wid * 1024;
    const LAS unsigned char* kp0 = lds + A_K + hi * 1024 + r32 * 16;
    const int vb0 = (int)(lds0 + A_V) + ((lane >> 4) & 1) * 32 + (lane & 3) * 8 + (4 * hi + ((lane & 15) >> 2)) * 64;
    LAS float* wsf = (LAS float*)(lds + A_WS) + wid * 64;
    const LAS float* lut = (const LAS float*)(lds + A_LUT) + P.lutoff;
    float carry = 0.f;
    if (tb < te) { glds16(ksrc + (size_t)tb * 64 * pitch, (unsigned)__builtin_amdgcn_readfirstlane(kdst));
                   if (MODE != MODE_CMPA) glds16(vsrc + (size_t)tb * 64 * pitch, (unsigned)__builtin_amdgcn_readfirstlane(vdst)); }
    for (int t = tb; t < te; ++t) {
        const int cur = ((t - tb) & 1) * SLOTB;
        ATT_WAIT_BAR0();
        if (t + 1 < te) { glds16(ksrc + (size_t)(t + 1) * 64 * pitch, (unsigned)__builtin_amdgcn_readfirstlane(kdst + (cur ^ SLOTB)));
                          if (MODE != MODE_CMPA) glds16(vsrc + (size_t)(t + 1) * 64 * pitch, (unsigned)__builtin_amdgcn_readfirstlane(vdst + (cur ^ SLOTB))); }
        if (MODE == MODE_FOX && t > tskip) continue;
        f32x16 p0, p1; qkt(p0, p1, kp0 + cur, qr);
        if constexpr (MODE == MODE_FOX) {
            const LAS float* fb = (const LAS float*)(lds + A_F) + 64 * t + 4 * hi;
#pragma unroll
            for (int a = 0; a < 4; ++a) { const f32x4 v = *(const LAS f32x4*)(fb + 8 * a), w = *(const LAS f32x4*)(fb + 32 + 8 * a);
#pragma unroll
                for (int i = 0; i < 4; ++i) { p0[4 * a + i] += v[i]; p1[4 * a + i] += w[i]; } }
            if (t >= P.tdiag) { const int d0 = P.tq - 64 * t - 4 * hi;
#pragma unroll
                for (int r = 0; r < 16; ++r) { const int kk = (r & 3) + 8 * (r >> 2); if (kk > d0) p0[r] = ATT_NEG; if (kk + 32 > d0) p1[r] = ATT_NEG; } }
        }
        if constexpr (MODE == MODE_SEL || MODE == MODE_WIN) {
            const int d0 = P.tq - 64 * t - 4 * hi;
            if (t + 3 <= P.ti) {
#pragma unroll
                for (int r = 0; r < 16; ++r) { p0[r] += P.b31; p1[r] += P.b31; }
                if (MODE == MODE_WIN && t + 8 == P.ti) {
#pragma unroll
                    for (int r = 0; r < 16; ++r) { const int kk = (r & 3) + 8 * (r >> 2); if (d0 - kk > 511) p0[r] = ATT_NEG; if (d0 - kk - 32 > 511) p1[r] = ATT_NEG; } }
            } else {
#pragma unroll
                for (int r = 0; r < 16; ++r) { const int kk = (r & 3) + 8 * (r >> 2); const int di = d0 - kk, dj = di - 32;
                    p0[r] += lut[di < 0 ? 0 : (di > 127 ? 127 : di)]; p1[r] += lut[dj < 0 ? 0 : (dj > 127 ? 127 : dj)];
                    if (di < 0) p0[r] = ATT_NEG; if (dj < 0) p1[r] = ATT_NEG; } }
            if (MODE == MODE_SEL) { if (!((P.sel >> t) & 1ull)) {
#pragma unroll
                for (int r = 0; r < 16; ++r) { p0[r] = ATT_NEG; p1[r] = ATT_NEG; } } }
        }
        if constexpr (MODE == MODE_CMPA || MODE == MODE_CMPB) {
            const int e0 = P.tq - 31 - 1024 * t - 64 * hi;
#pragma unroll
            for (int r = 0; r < 16; ++r) { const int kk = (r & 3) + 8 * (r >> 2); const int di = e0 - 16 * kk, dj = di - 512;
                p0[r] += lut[di < 0 ? 0 : (di > 127 ? 127 : di)]; p1[r] += lut[dj < 0 ? 0 : (dj > 127 ? 127 : dj)];
                if (di < 0) p0[r] = ATT_NEG; if (dj < 0) p1[r] = ATT_NEG; }
        }
        float rm = fmaxf(p0[0], p1[0]);
#pragma unroll
        for (int r = 1; r < 16; ++r) rm = fmaxf(rm, fmaxf(p0[r], p1[r]));
        rm = xhalf_max(rm);
        if constexpr (MODE == MODE_CMPA) { m = fmaxf(m, rm); continue; }
        if constexpr (MODE != MODE_CMPB) {
            if (__any(rm > m + 8.f)) { const float mn = fmaxf(m, rm); const float al = __builtin_amdgcn_exp2f(m - mn); m = mn; l *= al; o_rowscale(o, wsf, al, r32, hi, false, o); }
        }
        float sum = 0.f;
#pragma unroll
        for (int r = 0; r < 16; ++r) { p0[r] = __builtin_amdgcn_exp2f(p0[r] - m); p1[r] = __builtin_amdgcn_exp2f(p1[r] - m); sum += p0[r] + p1[r]; }
        l += sum;
        if constexpr (MODE == MODE_CMPB) {
            if (want_imp) { float x[4], y[4];
#pragma unroll
                for (int a = 0; a < 4; ++a) { x[a] = __shfl_xor(p0[4 * a + 3], 32); y[a] = __shfl_xor(p1[4 * a + 3], 32); }
#pragma unroll
                for (int a = 0; a < 4; ++a) {
                    const float pr0 = hi ? x[a] : (a ? x[a > 0 ? a - 1 : 0] : carry), pr1 = hi ? y[a] : (a ? y[a > 0 ? a - 1 : 0] : x[3]);
                    improw[16 * t + 2 * a + hi] = (p0[4 * a] + p0[4 * a + 1]) + (p0[4 * a + 2] + p0[4 * a + 3]) + pr0;
                    improw[16 * t + 8 + 2 * a + hi] = (p1[4 * a] + p1[4 * a + 1]) + (p1[4 * a + 2] + p1[4 * a + 3]) + pr1; }
                carry = y[3]; }
        }
        v4u w0, w1, w2, w3;
        w0.x = pk2(p0[0], p0[1]); w0.y = pk2(p0[2], p0[3]); w0.z = pk2(p0[4], p0[5]); w0.w = pk2(p0[6], p0[7]);
        w1.x = pk2(p0[8], p0[9]); w1.y = pk2(p0[10], p0[11]); w1.z = pk2(p0[12], p0[13]); w1.w = pk2(p0[14], p0[15]);
        w2.x = pk2(p1[0], p1[1]); w2.y = pk2(p1[2], p1[3]); w2.z = pk2(p1[4], p1[5]); w2.w = pk2(p1[6], p1[7]);
        w3.x = pk2(p1[8], p1[9]); w3.y = pk2(p1[10], p1[11]); w3.z = pk2(p1[12], p1[13]); w3.w = pk2(p1[14], p1[15]);
        pv(o, vb0 + cur, __builtin_bit_cast(bf16x8, w0), __builtin_bit_cast(bf16x8, w1), __builtin_bit_cast(bf16x8, w2), __builtin_bit_cast(bf16x8, w3));
    }
    ATT_LBAR();
}
__device__ __forceinline__ void store_o(LAS bf16* stg, const f32x16 (&o)[2], bf16* dst, int pitch, int lane) {
    const int r32 = lane & 31, hi = lane >> 5;
#pragma unroll
    for (int r = 0; r < 16; ++r) { const int orow = crow(r, hi);
#pragma unroll
        for (int d0 = 0; d0 < 2; ++d0) stg[orow * 64 + d0 * 32 + r32] = (bf16)(pk2(o[d0][r], 0.f) & 0xffffu); }
    LDS_WAIT();
#pragma unroll
    for (int i = 0; i < 4; ++i) { const int row = i * 8 + (lane >> 3), ch = lane & 7; const v4u v = *(const LAS v4u*)(stg + row * 64 + ch * 8); *(GAS v4u*)(dst + (size_t)row * pitch + ch * 8) = v; }
    LDS_WAIT();
}
__device__ __forceinline__ void fox_unit(Frame& F, int b, int h, int qb) {
    int tid_ = F.tid; asm volatile("" : "+v"(tid_));
    LAS unsigned char* lds = F.lds + RING_OFF; const int wid = __builtin_amdgcn_readfirstlane(tid_ >> 6), lane = tid_ & 63, r32 = lane & 31, hi = lane >> 5;
    const bf16* Z = (const bf16*)(F.ws + WS_Z); bf16* MIX = (bf16*)(F.ws + WS_MIX);
    const int q0 = 256 * qb; const size_t rowbase = (size_t)b * SEQ;
    { const GAS f32x4* src = (const GAS f32x4*)((const float*)(F.ws + WS_F2) + (size_t)(b * 12 + h) * SEQ); LAS f32x4* dst = (LAS f32x4*)(lds + A_F);
      for (int i = F.tid; i < (q0 + 256) / 4; i += NWAVES * 64) dst[i] = src[i]; }
    bf16x8 qr[4]; const bf16* qp = Z + (rowbase + q0 + 32 * wid + r32) * ZP + Z_FQ + h * 64 + hi * 8;
#pragma unroll
    for (int d0 = 0; d0 < 4; ++d0) qr[d0] = *(const GAS bf16x8*)(qp + d0 * 16);
    f32x16 o[2]; o[0] = f32x16{}; o[1] = f32x16{}; float m = -1e30f, l = 0.f;
    BrP P; P.tq = q0 + 32 * wid + r32; P.ti = 0; P.lutoff = 0; P.tdiag = 4 * qb; P.sel = 0ull; P.b31 = 0.f;
    run_branch<MODE_FOX>(lds, Z + rowbase * ZP + Z_FK + h * 64, Z + rowbase * ZP + Z_FV + h * 64, ZP, 0, 4 * qb + 4, qr, o, m, l, P, wid, lane, nullptr, false, (q0 + 32 * wid + 31) >> 6);
    l = xhalf_sum(l);
    o_rowscale(o, (LAS float*)(lds + A_WS) + wid * 64, l > 0.f ? 1.f / l : 0.f, r32, hi, false, o);
    store_o((LAS bf16*)(lds + A_OST) + wid * 2048, o, MIX + (rowbase + q0 + 32 * wid) * DM + h * 64, DM, lane);
    ATT_LBAR();
}
__device__ __forceinline__ void nsa_unit(Frame& F, int b, int g, int ti) {
    int tid_ = F.tid; asm volatile("" : "+v"(tid_));
    LAS unsigned char* lds = F.lds + RING_OFF; const int wid = __builtin_amdgcn_readfirstlane(tid_ >> 6), lane = tid_ & 63, r32 = lane & 31, hi = lane >> 5;
    const bf16* Z = (const bf16*)(F.ws + WS_Z); bf16* MIX = (bf16*)(F.ws + WS_MIX);
    const int head = wid >> 1, h = g * 4 + head, tokl = 32 * (wid & 1) + r32, t0 = 64 * ti, tq = t0 + tokl; const size_t rowbase = (size_t)b * SEQ;
    LAS float* wsf = (LAS float*)(lds + A_WS) + wid * 64;
    const bf16* zq = Z + (rowbase + tq) * ZP;
    bf16x8 qr[4];
#pragma unroll
    for (int d0 = 0; d0 < 4; ++d0) qr[d0] = *(const GAS bf16x8*)(zq + Z_NQ + h * 64 + hi * 8 + d0 * 16);
    const float g0 = sigm(bf1(zq[Z_NG + h * 3 + 0])), g1 = sigm(bf1(zq[Z_NG + h * 3 + 1])), g2 = sigm(bf1(zq[Z_NG + h * 3 + 2]));
    if (F.tid < 128) ((LAS unsigned*)(lds + A_SEL))[F.tid] = 0u;
    LAS float* otw = (LAS float*)(lds + A_OST) + wid * 2048;
    BrP P; P.tq = tq; P.ti = ti; P.lutoff = h * 128; P.tdiag = 0; P.sel = 0ull; P.b31 = ((const LAS float*)(lds + A_LUT))[h * 128 + 127];
    const bool need_topk = ti >= 16;
    f32x16 oc[2]; oc[0] = f32x16{}; oc[1] = f32x16{}; float fc = 0.f;
#ifndef X_NSA_NO_CMP
    { const bf16* Kc = (const bf16*)(F.ws + WS_KCMP) + (size_t)(b * 3 + g) * 256 * 64; const bf16* Vc = (const bf16*)(F.ws + WS_VCMP) + (size_t)(b * 3 + g) * 256 * 64;
      const int nct = (4 * ti + 66) >> 6;
      float m = -1e30f, l = 0.f;
      run_branch<MODE_CMPA>(lds, Kc, Vc, 64, 0, nct, qr, oc, m, l, P, wid, lane, nullptr, false, 0);
      run_branch<MODE_CMPB>(lds, Kc, Vc, 64, 0, nct, qr, oc, m, l, P, wid, lane, (LAS float*)(lds + A_IMPRAW) + (head * 64 + tokl) * 64, need_topk, 0);
      l = xhalf_sum(l); const float linv = l > 0.f ? 1.f / l : 0.f;
      if (hi == 0) ((LAS float*)(lds + A_LINV))[head * 64 + tokl] = linv;
      fc = g0 * linv;
    }
#endif
    unsigned long long sel = (ti == 63) ? ~0ull : ((1ull << (ti + 1)) - 1ull);
#ifndef X_NSA_NO_TOPK
    if (need_topk) {
        ATT_LBAR();
        { const int tok = F.tid >> 3, jg = (F.tid & 7) * 8; const LAS float* raw = (const LAS float*)(lds + A_IMPRAW); const LAS float* li = (const LAS float*)(lds + A_LINV);
          LAS float* imp2 = (LAS float*)(lds + A_IMP2) + tok * 65;
#pragma unroll
          for (int j = 0; j < 8; ++j) { float s = 0.f;
#pragma unroll
              for (int r = 0; r < 4; ++r) s += raw[(r * 64 + tok) * 64 + jg + j] * li[r * 64 + tok];
              imp2[jg + j] = (jg + j <= ti) ? s : 0.f; } }
        ATT_LBAR();
        { const int tok = F.tid >> 3, jg = (F.tid & 7) * 8; const LAS float* imp2 = (const LAS float*)(lds + A_IMP2) + tok * 65;
          unsigned bits = 0u;
#pragma unroll
          for (int j = 0; j < 8; ++j) { const int jj = jg + j; bool on;
              if (jj > ti) on = false;
              else if (jj == 0 || jj + 1 >= ti) on = true;
              else { const float v = imp2[jj]; int rank = 3;
                  for (int k = 1; k + 1 < ti; ++k) { const float ov = imp2[k]; rank += (ov > v || (ov == v && k < jj)) ? 1 : 0; }
                  on = rank < 16; }
              bits |= on ? (1u << j) : 0u; }
          if (bits) (void)__hip_atomic_fetch_or((LAS unsigned*)(lds + A_SEL) + tok * 2 + (jg >> 5), bits << (jg & 31), __ATOMIC_RELAXED, __HIP_MEMORY_SCOPE_WORKGROUP); }
        ATT_LBAR();
        { const LAS unsigned* sp = (const LAS unsigned*)(lds + A_SEL) + tokl * 2; sel = (unsigned long long)sp[0] | ((unsigned long long)sp[1] << 32); }
    }
#endif
    ot_update(otw, oc, wsf, fc, r32, hi, 0);
#ifndef X_NSA_NO_SEL
    { f32x16 o[2]; o[0] = f32x16{}; o[1] = f32x16{}; float m = -1e30f, l = 0.f; P.sel = sel;
      run_branch<MODE_SEL>(lds, Z + rowbase * ZP + Z_KS + g * 64, Z + rowbase * ZP + Z_VS + g * 64, ZP, 0, ti + 1, qr, o, m, l, P, wid, lane, nullptr, false, 0);
      l = xhalf_sum(l); ot_update(otw, o, wsf, l > 0.f ? g1 / l : 0.f, r32, hi, 1); }
#endif
#ifndef X_NSA_NO_WIN
    { f32x16 o[2]; o[0] = f32x16{}; o[1] = f32x16{}; float m = -1e30f, l = 0.f;
      run_branch<MODE_WIN>(lds, Z + rowbase * ZP + Z_KW + g * 64, Z + rowbase * ZP + Z_VW + g * 64, ZP, ti >= 8 ? ti - 8 : 0, ti + 1, qr, o, m, l, P, wid, lane, nullptr, false, 0);
      l = xhalf_sum(l); ot_update(otw, o, wsf, l > 0.f ? g2 / l : 0.f, r32, hi, 2);
      store_o((LAS bf16*)otw, o, MIX + (rowbase + t0 + 32 * (wid & 1)) * DM + 768 + h * 64, DM, lane); }
#endif
    ATT_LBAR();
}
struct OrderTab { unsigned short v[768]; };
constexpr int fox_cost(int qb) { return 4 * (qb + 1) + 1; }
constexpr int nsa_cost(int i) { return (i + 1) + (i + 1 < 9 ? i + 1 : 9) + 2 * ((4 * i + 66) >> 6) + 3; }
constexpr OrderTab make_order() {
    OrderTab T{}; int n = 0;
    for (int c = 100; c >= 0; --c) {
        for (int qb = 0; qb < 16; ++qb) if (fox_cost(qb) == c) for (int bh = 0; bh < 24; ++bh) T.v[n++] = (unsigned short)((bh << 4) | qb);
        for (int i = 0; i < 64; ++i) if (nsa_cost(i) == c) for (int bg = 0; bg < 6; ++bg) T.v[n++] = (unsigned short)(0x8000 | (bg << 6) | i);
    }
    return T;
}
__device__ const OrderTab g_order = make_order();
}
__device__ __forceinline__ void p_attn(Frame& F, KA A, int l) {
    LAS unsigned char* lds = F.lds + RING_OFF;
    { const GAS f32x4* src = (const GAS f32x4*)(F.ws + WS_LUT); LAS f32x4* dst = (LAS f32x4*)(lds + att::A_LUT); for (int i = F.tid; i < 12 * 128 / 4; i += NWAVES * 64) dst[i] = src[i]; }
    LDS_WAIT(); __syncthreads();
    LAS unsigned* qs = (LAS unsigned*)(lds + att::A_Q);
    for (;;) {
        if (F.tid == 0) qs[0] = __hip_atomic_fetch_add(F.ctl + CW_Q + 64 * l, 1u, RLX_AGENT);
        LDS_WAIT(); __syncthreads();
        const unsigned qi = qs[0];
        LDS_WAIT(); __syncthreads();
        if (qi >= 768u) break;
        const unsigned code = att::g_order.v[qi];
        if (code & 0x8000u) {
#ifndef X_NO_NSA
            if (A->flags & FL_NSA) { const int bg = (code >> 6) & 7; att::nsa_unit(F, bg / 3, bg % 3, (int)(code & 63u)); }
#endif
        }
        else {
#ifndef X_NO_FOX
            if (A->flags & FL_FOX) { const int bh = (code >> 4) & 31; att::fox_unit(F, bh / 12, bh % 12, (int)(code & 15u)); }
#endif
        }
    }
}
__global__ void __launch_bounds__(NWAVES * 64, 2) mk_fwd(Args args) {
    extern __shared__ __attribute__((aligned(16))) unsigned char lds[];
    Frame F;
    F.lds = (LAS unsigned char*)lds; F.MISC = (volatile LAS unsigned*)(F.lds + MISC_OFF);
    F.tid = threadIdx.x; F.lane = F.tid & 63; F.wave = __builtin_amdgcn_readfirstlane(F.tid >> 6);
    F.gw = blockIdx.x * NWAVES + F.wave; F.ngw = gridDim.x * NWAVES;
    F.ws = args.ws; F.ctl = (gu32*)(args.ws + WS_CTL);
    for (int u = F.tid; u < (LDS_BYTES - LDSCTL_OFF) / 4; u += NWAVES * 64) ((LAS unsigned*)(F.lds + LDSCTL_OFF))[u] = 0u;
    __syncthreads();
    const int lo = args.ph_lo, hi = args.ph_hi;
    XcdBarrier bar; bar.bar = (unsigned*)(F.ctl + CW_BAR); bar.x = 0; bar.st = nullptr;
    if (hi - lo > 1) bar = xcd_barrier_post((unsigned*)(F.ctl + CW_BAR), F.MISC + 8);
#define IN(k) (lo <= (k) && (k) < hi)
#define SEAM(k) do { if ((k) + 1 < hi) xcd_barrier(bar); } while (0)
#define WSP(T, off) ((T*)(kargs()->ws + (off)))
#define FRESH() do { asm volatile("" : "+v"(F.tid)); F.lane = F.tid & 63; F.wave = __builtin_amdgcn_readfirstlane(F.tid >> 6); F.gw = blockIdx.x * NWAVES + F.wave; F.ws = kargs()->ws; F.ctl = (gu32*)(F.ws + WS_CTL); } while (0)

    #ifndef X_NO_PRO
    if (IN(PH_PRO)) { FRESH(); p_prologue(F, kargs()); SEAM(PH_PRO); }
#endif
    if (IN(PH_FIN)) { FRESH(); p_modfin(F, kargs()); SEAM(PH_FIN); }
    for (int l = 0; l < NL; ++l) {
        const int pb = PH_L0 + PH_PER_LAYER * l;
#define XIN() ((l == 0) ? kargs()->in[IN_X] : WSP(const float, WS_X))
#define MODL() (WSP(const float, WS_MOD) + (size_t)l * 2 * MODW)
        if (IN(pb + LP_NORM1)) { FRESH(); p_norm(F, XIN(), kargs()->in[IN_N1G] + l * DM, MODL(), 0, DM, WSP(bf16, WS_XN)); SEAM(pb + LP_NORM1); }
#ifndef X_NO_GIN
        if (IN(pb + LP_GIN)) {
            pg8::Gemm g{WSP(bf16, WS_XN), WSP(const bf16, WS_WIN) + (size_t)l * ZP * DM, MTOK, ZP, DM}; pg8::StaticOrder S; S.init(MTOK, ZP, (int)gridDim.x, (int)blockIdx.x);
            pg8::EpiZ E{WSP(bf16, WS_Z), ZP, Z_QTILES, QSCALE};
            pg8::gemm_phase<pg8::EpiZ, pg8::StaticOrder, true, true>(F.lds + RING_OFF, g, S, E);
            SEAM(pb + LP_GIN); }
#endif
#ifndef X_NO_PRE
        if (IN(pb + LP_PRE)) { FRESH(); if (kargs()->flags & FL_PRE) p_pre(F, kargs(), l); SEAM(pb + LP_PRE); }
#endif
#ifndef X_NO_ATTN
        if (IN(pb + LP_ATTN)) { FRESH(); p_attn(F, kargs(), l); SEAM(pb + LP_ATTN); }
#endif
#ifndef X_NO_GOUT
        if (IN(pb + LP_GOUT)) {
            pg8::Gemm g{WSP(bf16, WS_MIX), WSP(const bf16, WS_WOUT) + (size_t)l * DM * DM, MTOK, DM, DM}; pg8::StaticOrder S; S.init(MTOK, DM, (int)gridDim.x, (int)blockIdx.x);
            pg8::EpiResGate E{XIN(), WSP(float, WS_X), DM, MODL() + 2 * DM, MODW, SEQ};
            pg8::gemm_phase<pg8::EpiResGate, pg8::StaticOrder, true, true>(F.lds + RING_OFF, g, S, E);
            SEAM(pb + LP_GOUT); }
#endif
        if (IN(pb + LP_NORM2)) { FRESH(); p_norm(F, WSP(const float, WS_X), kargs()->in[IN_N2G] + l * DM, MODL(), 3 * DM, 4 * DM, WSP(bf16, WS_XN)); SEAM(pb + LP_NORM2); }
#ifndef X_NO_G1
        if (IN(pb + LP_G1)) {
            pg8::Gemm g{WSP(bf16, WS_XN), WSP(const bf16, WS_W1) + (size_t)l * DFF * DM, MTOK, DFF, DM}; pg8::StaticOrder S; S.init(MTOK, DFF, (int)gridDim.x, (int)blockIdx.x);
            pg8::EpiRelu2 E{WSP(bf16, WS_HB), DFF};
            pg8::gemm_phase<pg8::EpiRelu2, pg8::StaticOrder, true, true>(F.lds + RING_OFF, g, S, E);
            SEAM(pb + LP_G1); }
#endif
#ifndef X_NO_G2
        if (IN(pb + LP_G2)) {
            pg8::Gemm g{WSP(bf16, WS_HB), WSP(const bf16, WS_W2) + (size_t)l * DM * DFF, MTOK, DM, DFF}; pg8::StaticOrder S; S.init(MTOK, DM, (int)gridDim.x, (int)blockIdx.x);
            pg8::EpiResGate E{WSP(const float, WS_X), WSP(float, WS_X), DM, MODL() + 5 * DM, MODW, SEQ};
            pg8::gemm_phase<pg8::EpiResGate, pg8::StaticOrder, true, true>(F.lds + RING_OFF, g, S, E);
            SEAM(pb + LP_G2); }
#endif
    }
    if (IN(PH_FINAL)) { FRESH(); p_final(F, WSP(const float, WS_X), kargs()->in[IN_FING], kargs()->out); }
#undef IN
#undef SEAM
}
#ifndef MK_MODE
#define MK_MODE 0
#endif
#ifndef MK_NAIVE
#define MK_NAIVE 0
#endif
#if MK_MODE == 2
namespace nv2 {
__device__ __forceinline__ float wmax(float v) { for (int o = 32; o; o >>= 1) v = fmaxf(v, __shfl_xor(v, o)); return v; }
__device__ __forceinline__ bf16 tobf(float v) { return (bf16)(pk2(v, 0.f) & 0xffffu); }
__global__ void __launch_bounds__(256) k_cumsum(const bf16* Z, const float* bfp, float* NF2) {
    __shared__ float sc[256];
    const int bh = blockIdx.x, b = bh / 12, h = bh % 12, tid = threadIdx.x, t0 = tid * 16;
    float run = 0.f;
    for (int i = 0; i < 16; ++i) run += logsig(bf1(Z[(size_t)(b * SEQ + t0 + i) * ZP + Z_FF + h]) + bfp[h]);
    sc[tid] = run; __syncthreads();
    float off = 0.f; for (int k = 0; k < tid; ++k) off += sc[k];
    run = off;
    for (int i = 0; i < 16; ++i) { run += logsig(bf1(Z[(size_t)(b * SEQ + t0 + i) * ZP + Z_FF + h]) + bfp[h]); NF2[(size_t)bh * SEQ + t0 + i] = -LOG2E * run; }
}
__global__ void __launch_bounds__(64) k_compress(const bf16* Z, const float* wk, const float* wv, const float* pos, bf16* KC, bf16* VC) {
    const int idx = blockIdx.x, n = idx % 256, g = (idx / 256) % 3, b = idx / (3 * 256), e = threadIdx.x;
    float ak = 0.f, av = 0.f;
    if (n < 255) for (int l = 0; l < 32; ++l) { const bf16* zr = Z + (size_t)(b * SEQ + 16 * n + l) * ZP;
        for (int d = 0; d < 64; ++d) { const float pk = pos[l * 64 + d]; ak += (bf1(zr[Z_KC + g * 64 + d]) + pk) * wk[(l * 64 + d) * 64 + e]; av += (bf1(zr[Z_VC + g * 64 + d]) + pk) * wv[(l * 64 + d) * 64 + e]; } }
    KC[(size_t)idx * 64 + e] = tobf(ak); VC[(size_t)idx * 64 + e] = tobf(av);
}
__device__ __forceinline__ float dotz(const float* q, const bf16* k) { float a = 0.f;
#pragma unroll 16
    for (int d = 0; d < 64; ++d) a += q[d] * bf1(k[d]); return a; }
__global__ void __launch_bounds__(64) k_nsa(const bf16* Z, const bf16* KC, const bf16* VC, const float* relb, bf16* MIX) {
    __shared__ float q[4][64]; __shared__ float sc[4][1024]; __shared__ float impv[64];
    const int idx = blockIdx.x, t = idx % SEQ, g = (idx / SEQ) % 3, b = idx / (3 * SEQ), lane = threadIdx.x;
    const bf16* zrow = Z + (size_t)(b * SEQ + t) * ZP;
    for (int r = 0; r < 4; ++r) q[r][lane] = bf1(zrow[Z_NQ + (g * 4 + r) * 64 + lane]);
    __syncthreads();
    float oc[4], os[4], ow[4];
    const int nvalid = t >= 31 ? ((t - 31) / 16 + 1 < 255 ? (t - 31) / 16 + 1 : 255) : 0;
    for (int n = lane; n < 256; n += 64)
        for (int r = 0; r < 4; ++r) { float s = -INFINITY;
            if (n < nvalid) s = dotz(q[r], KC + (size_t)((b * 3 + g) * 256 + n) * 64) + LOG2E * relb[t5_bucket(t - (16 * n + 31)) * 12 + g * 4 + r];
            sc[r][n] = s; }
    __syncthreads();
    for (int r = 0; r < 4; ++r) { float m = -INFINITY; for (int n = lane; n < 256; n += 64) m = fmaxf(m, sc[r][n]); m = wmax(m);
        float e[4], sum = 0.f;
#pragma unroll
        for (int i = 0; i < 4; ++i) { const float s = sc[r][lane + 64 * i]; e[i] = (s == -INFINITY) ? 0.f : exp2f(s - m); sum += e[i]; }
        sum = wave_sum(sum); const float inv = sum > 0.f ? 1.f / sum : 0.f;
#pragma unroll
        for (int i = 0; i < 4; ++i) sc[r][lane + 64 * i] = e[i] * inv; }
    __syncthreads();
#pragma unroll
    for (int r = 0; r < 4; ++r) { float a = 0.f; for (int n = 0; n < nvalid; ++n) a += sc[r][n] * bf1(VC[(size_t)((b * 3 + g) * 256 + n) * 64 + lane]); oc[r] = a; }
    { float im = 0.f; for (int r = 0; r < 4; ++r) for (int n = 4 * lane - 1; n <= 4 * lane + 3; ++n) if (n >= 0 && n < 255) im += sc[r][n];
      const int cur = t / 64; const bool forced = (lane == 0) || (lane == cur) || (lane == cur - 1); const bool valid = 64 * lane <= t;
      impv[lane] = forced ? 1e9f : (valid ? im : -1e30f); }
    __syncthreads();
    unsigned long long selm;
    { const float val = impv[lane]; int rank = 0; for (int k = 0; k < 64; ++k) { const float o = impv[k]; rank += (o > val || (o == val && k < lane)) ? 1 : 0; }
      selm = __ballot(rank < 16 && 64 * lane <= t); }
    __syncthreads();
    int nslot = 0;
    for (unsigned long long mm = selm; mm; mm &= mm - 1) { const int j = __builtin_ctzll(mm); const int tok = 64 * j + lane;
        for (int r = 0; r < 4; ++r) { float s = -INFINITY;
            if (tok <= t) s = dotz(q[r], Z + (size_t)(b * SEQ + tok) * ZP + Z_KS + g * 64) + LOG2E * relb[t5_bucket(t - tok) * 12 + g * 4 + r];
            sc[r][nslot * 64 + lane] = s; }
        ++nslot; }
    __syncthreads();
    for (int r = 0; r < 4; ++r) { float m = -INFINITY; for (int p = 0; p < nslot; ++p) m = fmaxf(m, sc[r][p * 64 + lane]); m = wmax(m);
        float sum = 0.f; for (int p = 0; p < nslot; ++p) { const float s = sc[r][p * 64 + lane]; const float e = (s == -INFINITY) ? 0.f : exp2f(s - m); sc[r][p * 64 + lane] = e; sum += e; }
        sum = wave_sum(sum); const float inv = sum > 0.f ? 1.f / sum : 0.f;
        for (int p = 0; p < nslot; ++p) sc[r][p * 64 + lane] *= inv; }
    __syncthreads();
#pragma unroll
    for (int r = 0; r < 4; ++r) os[r] = 0.f;
    { int p = 0; for (unsigned long long mm = selm; mm; mm &= mm - 1, ++p) { const int j = __builtin_ctzll(mm);
        for (int kk = 0; kk < 64; ++kk) { const float vv = bf1(Z[(size_t)(b * SEQ + 64 * j + kk) * ZP + Z_VS + g * 64 + lane]);
#pragma unroll
            for (int r = 0; r < 4; ++r) os[r] += sc[r][p * 64 + kk] * vv; } } }
    __syncthreads();
    for (int i = 0; i < 8; ++i) { const int s_ = t - 511 + lane + 64 * i;
        for (int r = 0; r < 4; ++r) { float s = -INFINITY;
            if (s_ >= 0) s = dotz(q[r], Z + (size_t)(b * SEQ + s_) * ZP + Z_KW + g * 64) + LOG2E * relb[t5_bucket(t - s_) * 12 + g * 4 + r];
            sc[r][i * 64 + lane] = s; } }
    __syncthreads();
    for (int r = 0; r < 4; ++r) { float m = -INFINITY; for (int p = 0; p < 8; ++p) m = fmaxf(m, sc[r][p * 64 + lane]); m = wmax(m);
        float sum = 0.f; for (int p = 0; p < 8; ++p) { const float s = sc[r][p * 64 + lane]; const float e = (s == -INFINITY) ? 0.f : exp2f(s - m); sc[r][p * 64 + lane] = e; sum += e; }
        sum = wave_sum(sum); const float inv = sum > 0.f ? 1.f / sum : 0.f;
        for (int p = 0; p < 8; ++p) sc[r][p * 64 + lane] *= inv; }
    __syncthreads();
#pragma unroll
    for (int r = 0; r < 4; ++r) ow[r] = 0.f;
    for (int kk = 0; kk < 512; ++kk) { const int s_ = t - 511 + kk; if (s_ < 0) continue; const float vv = bf1(Z[(size_t)(b * SEQ + s_) * ZP + Z_VW + g * 64 + lane]);
#pragma unroll
        for (int r = 0; r < 4; ++r) ow[r] += sc[r][kk] * vv; }
#pragma unroll
    for (int r = 0; r < 4; ++r) { const int h = g * 4 + r; const float g0 = sigm(bf1(zrow[Z_NG + h * 3 + 0])), g1 = sigm(bf1(zrow[Z_NG + h * 3 + 1])), g2 = sigm(bf1(zrow[Z_NG + h * 3 + 2]));
        MIX[(size_t)(b * SEQ + t) * DM + 768 + h * 64 + lane] = tobf(g0 * oc[r] + g1 * os[r] + g2 * ow[r]); }
}
__global__ void __launch_bounds__(64) k_fox(const bf16* Z, const float* NF2, bf16* MIX) {
    __shared__ float q[64]; __shared__ float sc[SEQ];
    const int idx = blockIdx.x, t = idx % SEQ, h = (idx / SEQ) % 12, b = idx / (12 * SEQ), lane = threadIdx.x;
    q[lane] = bf1(Z[(size_t)(b * SEQ + t) * ZP + Z_FQ + h * 64 + lane]);
    __syncthreads();
    const float* Fh = NF2 + (size_t)(b * 12 + h) * SEQ;
    float m = -INFINITY;
    for (int s = lane; s <= t; s += 64) { const float v = dotz(q, Z + (size_t)(b * SEQ + s) * ZP + Z_FK + h * 64) + Fh[s]; sc[s] = v; m = fmaxf(m, v); }
    m = wmax(m); float sum = 0.f;
    for (int s = lane; s <= t; s += 64) { const float e = exp2f(sc[s] - m); sc[s] = e; sum += e; }
    sum = wave_sum(sum);
    __syncthreads();
    float o = 0.f; for (int s = 0; s <= t; ++s) o += sc[s] * bf1(Z[(size_t)(b * SEQ + s) * ZP + Z_FV + h * 64 + lane]);
    MIX[(size_t)(b * SEQ + t) * DM + h * 64 + lane] = tobf(o / sum);
}
__global__ void __launch_bounds__(512) k_conv(const bf16* Z, const float* w, const float* bias, const float* lg, const float* lb, bf16* MIX) {
    __shared__ float red[8]; __shared__ float red2[8];
    const int row = blockIdx.x, b = row / SEQ, t = row % SEQ, c = threadIdx.x;
    float y = 0.f;
    for (int k = 0; k < 31; ++k) { const int tt = t - 30 + k; if (tt < 0) continue; const bf16* zr = Z + (size_t)(b * SEQ + tt) * ZP; y += bf1(zr[Z_CA + c]) * sigm(bf1(zr[Z_CG + c])) * w[k * 512 + c]; }
    y += bias[c];
    float s1 = wave_sum(y); if ((c & 63) == 0) red[c >> 6] = s1; __syncthreads();
    float mu = 0.f; for (int i = 0; i < 8; ++i) mu += red[i]; mu *= (1.f / 512.f);
    const float dy = y - mu; float s2 = wave_sum(dy * dy); if ((c & 63) == 0) red2[c >> 6] = s2; __syncthreads();
    float var = 0.f; for (int i = 0; i < 8; ++i) var += red2[i]; var *= (1.f / 512.f);
    const float yn = dy * rsqrtf(var + 1e-6f) * lg[c] + lb[c];
    MIX[(size_t)row * DM + 1536 + c] = tobf(yn * sigm(yn));
}
}
#endif

extern "C" void kernel_launch(void* const* d_in, const int* in_sizes, int n_in, void* d_out, int out_size, void* d_ws, size_t ws_size, hipStream_t stream) {
    static int grid = 0;
    if (grid == 0) {
        if (n_in != 20 || in_sizes[0] != MTOK * DM || out_size != MTOK * DM || ws_size < WS_END) { fprintf(stderr, "kernel_launch: unexpected shapes (n_in %d, in0 %d, out %d, ws %zu); nothing launched\n", n_in, n_in > 0 ? in_sizes[0] : -1, out_size, ws_size); grid = -1; return; }
        int dev = 0, cus = 0, per_cu = 0;
        if (hipGetDevice(&dev) != hipSuccess || hipDeviceGetAttribute(&cus, hipDeviceAttributeMultiprocessorCount, dev) != hipSuccess) { grid = -1; return; }
        if (hipFuncSetAttribute((const void*)mk_fwd, hipFuncAttributeMaxDynamicSharedMemorySize, LDS_BYTES) != hipSuccess) { fprintf(stderr, "kernel_launch: hipFuncSetAttribute failed\n"); grid = -1; return; }
        if (hipOccupancyMaxActiveBlocksPerMultiprocessor(&per_cu, (const void*)mk_fwd, NWAVES * 64, LDS_BYTES) != hipSuccess || per_cu < 1) { fprintf(stderr, "kernel_launch: occupancy query says %d blocks per CU\n", per_cu); }
        (void)hipGetLastError();
        grid = cus;
    }
    if (grid < 0) return;
    if (hipMemsetAsync((char*)d_ws + WS_CTL, 0, CTL_ZERO_BYTES, stream) != hipSuccess) return;
    Args a{};
    for (int i = 0; i < 20; ++i) a.in[i] = (const float*)d_in[i];
    a.out = (float*)d_out; a.ws = (unsigned char*)d_ws; a.flags = FL_FOX | FL_NSA | FL_PRE; a.pad = 0;
#if MK_MODE == 0
    a.ph_lo = 0; a.ph_hi = NPH;
    hipLaunchKernelGGL(mk_fwd, dim3(grid), dim3(NWAVES * 64), LDS_BYTES, stream, a);
#else
#if MK_MODE == 2
    if (MK_NAIVE & 1) a.flags &= ~FL_PRE;
    if (MK_NAIVE & 2) a.flags &= ~FL_FOX;
    if (MK_NAIVE & 4) a.flags &= ~FL_NSA;
    unsigned char* ws = (unsigned char*)d_ws; const bf16* Zb = (const bf16*)(ws + WS_Z); bf16* MIXb = (bf16*)(ws + WS_MIX); float* NF2 = (float*)(ws + WS_F2); bf16* KC = (bf16*)(ws + WS_KCMP); bf16* VC = (bf16*)(ws + WS_VCMP);
#endif
    for (int p = 0; p < NPH; ++p) {
        a.ph_lo = p; a.ph_hi = p + 1;
        hipLaunchKernelGGL(mk_fwd, dim3(grid), dim3(NWAVES * 64), LDS_BYTES, stream, a);
#if MK_MODE == 2
        const int lp = (p - PH_L0) % PH_PER_LAYER, l = (p - PH_L0) / PH_PER_LAYER;
        if (p >= PH_L0 && p < PH_FINAL && lp == LP_PRE && (MK_NAIVE & 1)) {
            hipLaunchKernelGGL(nv2::k_cumsum, dim3(NB * 12), dim3(256), 0, stream, Zb, a.in[IN_BF] + l * 12, NF2);
            hipLaunchKernelGGL(nv2::k_compress, dim3(NB * 3 * 256), dim3(64), 0, stream, Zb, a.in[IN_WCK] + (size_t)l * 32 * 64 * 64, a.in[IN_WCV] + (size_t)l * 32 * 64 * 64, a.in[IN_POS] + l * 32 * 64, KC, VC);
            hipLaunchKernelGGL(nv2::k_conv, dim3(MTOK), dim3(512), 0, stream, Zb, a.in[IN_CW] + (size_t)l * 31 * 512, a.in[IN_CB] + l * 512, a.in[IN_CLG] + l * 512, a.in[IN_CLB] + l * 512, MIXb); }
        if (p >= PH_L0 && p < PH_FINAL && lp == LP_ATTN) {
            if (MK_NAIVE & 2) hipLaunchKernelGGL(nv2::k_fox, dim3(NB * 12 * SEQ), dim3(64), 0, stream, Zb, NF2, MIXb);
            if (MK_NAIVE & 4) hipLaunchKernelGGL(nv2::k_nsa, dim3(NB * 3 * SEQ), dim3(64), 0, stream, Zb, KC, VC, a.in[IN_RELB], MIXb); }
#endif
    }
#endif
}
```

```cpp
#include <hip/hip_runtime.h>
#include <cstdio>
#include <cstdint>
#include <math.h>
#define MK_MODE 0
namespace pg8 {
#define PG8_LAS __attribute__((address_space(3)))
typedef unsigned short bf16_t;
typedef short bf16x8 __attribute__((ext_vector_type(8)));
typedef float f32x4 __attribute__((ext_vector_type(4)));
typedef unsigned u32x4 __attribute__((ext_vector_type(4)));
constexpr int BM = 256, BK = 64, HALF = 128, HTB = HALF * BK * 2  , STAGE_BYTES = 8 * HTB, NXCD = 8, WGM = 8;

__host__ __device__ __forceinline__ int lds_byte(int r, int c) { const int st = (r >> 4) * 2 + (c >> 5), rr = r & 15, cc = c & 31, ob = rr * 64 + cc * 2; return st * 1024 + (ob ^ (((ob >> 9) & 1) << 5)); }
__host__ __device__ __forceinline__ void stage_rc(int b, int& R, int& C) { const int st = b / 1024, sb = b % 1024, swz = sb ^ (((sb >> 9) & 1) << 5); R = (st >> 1) * 16 + swz / 64; C = (st & 1) * 32 + (swz % 64) / 2; }
__host__ __device__ __forceinline__ int perm32(int rho) { const int n = rho >> 4, i = rho & 15; return 8 * (i >> 2) + 4 * n + (i & 3); }

struct Unit { int pm, pn; };
struct Gemm { const bf16_t* A; const bf16_t* Bt; int M, N, K; };

struct StaticOrder {
    int nM, nN, nwg, G, c;
    __host__ __device__ void init(int M, int N, int G_, int c_) { nM = M / BM; nN = N / BM; nwg = nM * nN; G = G_; c = c_; }
    __host__ __device__ bool next(int i, Unit& u) const {
        const long L = (long)i * G + c; if (L >= nwg) return false;
        int wgid = (int)L; { const int q = nwg / NXCD, r = nwg % NXCD, xcd = wgid % NXCD, off = wgid / NXCD; wgid = (xcd < r ? xcd * (q + 1) : r * (q + 1) + (xcd - r) * q) + off; }
        const int nig = WGM * nN, gid = wgid / nig, fm = gid * WGM, gsz = (nM - fm) < WGM ? (nM - fm) : WGM;
        u.pm = fm + ((wgid % nig) % gsz); u.pn = (wgid % nig) / gsz; return true;
    }
    __device__ __forceinline__ void a_ready(const Unit&) const {}
    __device__ __forceinline__ void done(const Unit&) const {}
};

__device__ __forceinline__ unsigned cvt_pk_bf16(float lo, float hi) { unsigned r; asm volatile("v_cvt_pk_bf16_f32 %0, %1, %2" : "=v"(r) : "v"(lo), "v"(hi)); return r; }
typedef float f32x2 __attribute__((ext_vector_type(2)));
struct EpiZ {
    static constexpr bool PERM = true, AFTER_DRAIN = false;
    bf16_t* O; int ldc; unsigned scale_mask; float sc; int glu_tile0;
    __device__ __forceinline__ void operator()(const f32x4 (&acc)[2][2][4][2], const Unit& u, int wr, int wc, int fr, int fq) const {
        const int row0 = u.pm * BM + wr * 64 + fr; const int col0 = u.pn * BM + wc * 32 + 8 * fq;
        const float s = ((scale_mask >> u.pn) & 1u) ? sc : 1.f;
        if (u.pn >= glu_tile0) {
#pragma unroll
            for (int ai = 0; ai < 2; ++ai)
#pragma unroll
                for (int m = 0; m < 4; ++m) { bf16_t* rowp = O + (size_t)(row0 + ai * HALF + m * 16) * ldc + col0;
                    f32x4 v0 = acc[ai][0][m][0], v1 = acc[ai][0][m][1]; const f32x4 g0 = acc[ai][1][m][0], g1 = acc[ai][1][m][1];
#pragma unroll
                    for (int i = 0; i < 4; ++i) { v0[i] = v0[i] * __builtin_amdgcn_rcpf(1.f + __expf(-g0[i])); v1[i] = v1[i] * __builtin_amdgcn_rcpf(1.f + __expf(-g1[i])); }
                    u32x4 w; w.x = cvt_pk_bf16(v0[0], v0[1]); w.y = cvt_pk_bf16(v0[2], v0[3]); w.z = cvt_pk_bf16(v1[0], v1[1]); w.w = cvt_pk_bf16(v1[2], v1[3]);
                    *(u32x4*)(rowp) = w; }
            return; }
#pragma unroll
        for (int ai = 0; ai < 2; ++ai)
#pragma unroll
            for (int m = 0; m < 4; ++m) { bf16_t* rowp = O + (size_t)(row0 + ai * HALF + m * 16) * ldc + col0;
#pragma unroll
                for (int bj = 0; bj < 2; ++bj) { const f32x4 v0 = acc[ai][bj][m][0] * s, v1 = acc[ai][bj][m][1] * s;
                    u32x4 w; w.x = cvt_pk_bf16(v0[0], v0[1]); w.y = cvt_pk_bf16(v0[2], v0[3]); w.z = cvt_pk_bf16(v1[0], v1[1]); w.w = cvt_pk_bf16(v1[2], v1[3]);
                    *(u32x4*)(rowp + bj * HALF) = w; } }
    }
};
struct EpiRelu2 {
    static constexpr bool PERM = true, AFTER_DRAIN = false;
    bf16_t* O; int ldc;
    __device__ __forceinline__ void operator()(const f32x4 (&acc)[2][2][4][2], const Unit& u, int wr, int wc, int fr, int fq) const {
        const int row0 = u.pm * BM + wr * 64 + fr; const int col0 = u.pn * BM + wc * 32 + 8 * fq;
#pragma unroll
        for (int ai = 0; ai < 2; ++ai)
#pragma unroll
            for (int m = 0; m < 4; ++m) { bf16_t* rowp = O + (size_t)(row0 + ai * HALF + m * 16) * ldc + col0;
#pragma unroll
                for (int bj = 0; bj < 2; ++bj) { f32x4 v0 = acc[ai][bj][m][0], v1 = acc[ai][bj][m][1];
#pragma unroll
                    for (int i = 0; i < 4; ++i) { v0[i] = v0[i] > 0.f ? v0[i] : 0.f; v1[i] = v1[i] > 0.f ? v1[i] : 0.f; }
                    v0 = v0 * v0; v1 = v1 * v1;
                    u32x4 w; w.x = cvt_pk_bf16(v0[0], v0[1]); w.y = cvt_pk_bf16(v0[2], v0[3]); w.z = cvt_pk_bf16(v1[0], v1[1]); w.w = cvt_pk_bf16(v1[2], v1[3]);
                    *(u32x4*)(rowp + bj * HALF) = w; } }
    }
};
struct EpiResGate {
    static constexpr bool PERM = false, AFTER_DRAIN = false;
    const float* base; float* out; int ldc; const float* gate; int gpitch; int rows_per_batch;
    __device__ __forceinline__ void operator()(const f32x4 (&acc)[2][2][4][2], const Unit& u, int wr, int wc, int fr, int fq) const {
        const int col0 = u.pn * BM + wc * 32 + 4 * fq; const int b = (u.pm * BM) / rows_per_batch;
        f32x4 gv[2][2];
#pragma unroll
        for (int bj = 0; bj < 2; ++bj)
#pragma unroll
            for (int n = 0; n < 2; ++n) gv[bj][n] = *(const f32x4*)(gate + (size_t)b * gpitch + col0 + bj * HALF + n * 16);
#pragma unroll
        for (int ai = 0; ai < 2; ++ai)
#pragma unroll
            for (int m = 0; m < 4; ++m) { const size_t off = (size_t)(u.pm * BM + ai * HALF + wr * 64 + m * 16 + fr) * ldc + col0;
#pragma unroll
                for (int bj = 0; bj < 2; ++bj)
#pragma unroll
                    for (int n = 0; n < 2; ++n) { const f32x4 bs = *(const f32x4*)(base + off + bj * HALF + n * 16);
                        *(f32x4*)(out + off + bj * HALF + n * 16) = bs + gv[bj][n] * acc[ai][bj][m][n]; }
                if (m & 1) asm volatile("" ::: "memory"); }
    }
};
template <class Epi, class Sched, bool ALIGN_EPI = false, bool SP2 = false>
__device__ __forceinline__ void gemm_phase(PG8_LAS unsigned char* lds, const Gemm g, const Sched& S, const Epi& E) {
    int tid_ = threadIdx.x; asm volatile("" : "+v"(tid_));
    const int tid = tid_, wid = __builtin_amdgcn_readfirstlane(tid >> 6), lane = tid & 63, wr = wid >> 2, wc = wid & 3, fr = lane & 15, fq = lane >> 4;
    const int K = g.K, nt = K / BK;
    unsigned voffA[2], voffB[2];
#pragma unroll
    for (int i = 0; i < 2; ++i) { int R, C; stage_rc(tid * 16 + i * 8192, R, C); const int Rb = Epi::PERM ? ((R & ~31) + perm32(R & 31)) : R;
        voffA[i] = (unsigned)(R * K + C) * 2u; voffB[i] = (unsigned)(Rb * K + C) * 2u; }
    const size_t kstep = (size_t)(BK * 2);
    const size_t hstep = (size_t)HALF * K * 2;
    const size_t tstep = 2 * hstep;
    const unsigned ldsw = (unsigned)wid * 1024u;
    const int aoff = lds_byte(wr * 64 + fr, fq * 8), boff = lds_byte(wc * 32 + fr, fq * 8);
#define PG8_SA(b, h) (((b) * 2 + (h)) * HTB)
#define PG8_SB(b, h) ((4 + (b) * 2 + (h)) * HTB)
#define PG8_STAGE(bufoff, gbase, voff) do { _Pragma("unroll") for (int _i = 0; _i < 2; ++_i) \
        __builtin_amdgcn_global_load_lds((const unsigned*)((const char*)(gbase) + (voff)[_i]), (PG8_LAS unsigned*)(lds + (bufoff) + ldsw + _i * 8192), 16, 0, 0); } while (0)
#define PG8_LDA(dst, b, h) do { _Pragma("unroll") for (int m = 0; m < 4; ++m) _Pragma("unroll") for (int k = 0; k < 2; ++k) dst[m][k] = *(const PG8_LAS bf16x8*)(lds + PG8_SA(b, h) + aoff + m * 2048 + k * 1024); } while (0)
#define PG8_LDB(dst, b, h) do { _Pragma("unroll") for (int n = 0; n < 2; ++n) _Pragma("unroll") for (int k = 0; k < 2; ++k) dst[n][k] = *(const PG8_LAS bf16x8*)(lds + PG8_SB(b, h) + boff + n * 2048 + k * 1024); } while (0)
#define PG8_MMA(ai, bj, At, Bt) do { __builtin_amdgcn_s_setprio(1); _Pragma("unroll") for (int m = 0; m < 4; ++m) _Pragma("unroll") for (int n = 0; n < 2; ++n) _Pragma("unroll") for (int k = 0; k < 2; ++k) \
        acc[ai][bj][m][n] = __builtin_amdgcn_mfma_f32_16x16x32_bf16(Bt[n][k], At[m][k], acc[ai][bj][m][n], 0, 0, 0); __builtin_amdgcn_s_setprio(0); } while (0)
#define PG8_WAIT_V(n) asm volatile("s_waitcnt vmcnt(" #n ")" ::: "memory")
#define PG8_WAIT_L(n) asm volatile("s_waitcnt lgkmcnt(" #n ")" ::: "memory")
#define PG8_BAR __builtin_amdgcn_s_barrier()
#define PG8_SCHED __builtin_amdgcn_sched_barrier(0)
    Unit cur, nxt; int ui = 0;
    if (!S.next(0, cur)) return;
    f32x4 acc[2][2][4][2];
#pragma unroll
    for (int a = 0; a < 2; ++a)
#pragma unroll
        for (int b = 0; b < 2; ++b)
#pragma unroll
            for (int m = 0; m < 4; ++m)
#pragma unroll
                for (int n = 0; n < 2; ++n) acc[a][b][m][n] = (f32x4){0.f, 0.f, 0.f, 0.f};
    bf16x8 At[4][2], B0[2][2], B1[2][2];
    const char* cA = (const char*)g.A + (size_t)cur.pm * tstep; const char* cB = (const char*)g.Bt + (size_t)cur.pn * tstep;
    S.a_ready(cur);
    if constexpr (SP2) {
        PG8_STAGE(PG8_SB(0, 0), cB, voffB); PG8_STAGE(PG8_SB(0, 1), cB + hstep, voffB); PG8_STAGE(PG8_SA(0, 0), cA, voffA); PG8_STAGE(PG8_SA(0, 1), cA + hstep, voffA);
        if (wr == 1) PG8_BAR;
        PG8_WAIT_V(2); PG8_BAR;
        PG8_STAGE(PG8_SB(1, 0), cB + kstep, voffB); PG8_STAGE(PG8_SA(1, 0), cA + kstep, voffA); PG8_STAGE(PG8_SB(1, 1), cB + hstep + kstep, voffB);
        PG8_WAIT_V(6); PG8_BAR;
    } else {
        PG8_STAGE(PG8_SB(0, 0), cB, voffB); PG8_STAGE(PG8_SA(0, 0), cA, voffA); PG8_STAGE(PG8_SB(0, 1), cB + hstep, voffB); PG8_STAGE(PG8_SA(0, 1), cA + hstep, voffA);
        if (wr == 1) PG8_BAR;
        PG8_WAIT_V(4); PG8_BAR;
        PG8_STAGE(PG8_SB(1, 0), cB + kstep, voffB); PG8_STAGE(PG8_SA(1, 0), cA + kstep, voffA); PG8_STAGE(PG8_SB(1, 1), cB + hstep + kstep, voffB);
        PG8_WAIT_V(6); PG8_BAR;
    }
    for (;;) {
        const bool has_next = S.next(ui + 1, nxt);
        const char* nA = has_next ? (const char*)g.A + (size_t)nxt.pm * tstep : cA; const char* nB = has_next ? (const char*)g.Bt + (size_t)nxt.pn * tstep : cB;
        for (int t = 0; t < nt; t += 2) {
            const bool last = (t == nt - 2);
            const char* a1 = cA + (size_t)(t + 1) * kstep;
            const char* a2 = last ? nA : cA + (size_t)(t + 2) * kstep; const char* b2 = last ? nB : cB + (size_t)(t + 2) * kstep;
            const char* a3 = a2 + kstep; const char* b3 = b2 + kstep;
            if (last && has_next) S.a_ready(nxt);
            if constexpr (SP2) {
            PG8_LDB(B0, 0, 0); PG8_LDB(B1, 0, 1); PG8_SCHED; PG8_LDA(At, 0, 0); PG8_STAGE(PG8_SA(1, 1), a1 + hstep, voffA);
            PG8_WAIT_V(8); PG8_WAIT_L(0); PG8_BAR; PG8_MMA(0, 0, At, B0); PG8_MMA(0, 1, At, B1); PG8_BAR; PG8_SCHED;
            PG8_LDA(At, 0, 1); PG8_STAGE(PG8_SB(0, 0), b2, voffB); PG8_STAGE(PG8_SB(0, 1), b2 + hstep, voffB); PG8_STAGE(PG8_SA(0, 0), a2, voffA);
            PG8_WAIT_V(8); PG8_WAIT_L(0); PG8_BAR; PG8_MMA(1, 0, At, B0); PG8_MMA(1, 1, At, B1); PG8_BAR; PG8_SCHED;
            PG8_LDB(B0, 1, 0); PG8_LDB(B1, 1, 1); PG8_SCHED; PG8_LDA(At, 1, 0); PG8_STAGE(PG8_SA(0, 1), a2 + hstep, voffA);
            PG8_WAIT_V(8); PG8_WAIT_L(0); PG8_BAR; PG8_MMA(0, 0, At, B0); PG8_MMA(0, 1, At, B1); PG8_BAR; PG8_SCHED;
            PG8_LDA(At, 1, 1); PG8_STAGE(PG8_SB(1, 0), b3, voffB); PG8_STAGE(PG8_SB(1, 1), b3 + hstep, voffB); PG8_STAGE(PG8_SA(1, 0), a3, voffA);
            PG8_WAIT_V(8); PG8_WAIT_L(0); PG8_BAR; PG8_MMA(1, 0, At, B0); PG8_MMA(1, 1, At, B1); PG8_BAR; PG8_SCHED;
            } else {
            PG8_LDB(B0, 0, 0); PG8_SCHED; PG8_LDA(At, 0, 0); PG8_STAGE(PG8_SA(1, 1), a1 + hstep, voffA);
            PG8_WAIT_L(8); PG8_BAR; PG8_WAIT_L(0); PG8_MMA(0, 0, At, B0); PG8_BAR; PG8_SCHED;
            PG8_LDB(B1, 0, 1); PG8_STAGE(PG8_SB(0, 0), b2, voffB);
            PG8_BAR; PG8_WAIT_L(0); PG8_MMA(0, 1, At, B1); PG8_BAR;
            PG8_LDA(At, 0, 1); PG8_STAGE(PG8_SA(0, 0), a2, voffA);
            PG8_BAR; PG8_WAIT_L(0); PG8_MMA(1, 0, At, B0); PG8_BAR; PG8_SCHED;
            PG8_STAGE(PG8_SB(0, 1), b2 + hstep, voffB);
            PG8_WAIT_V(6); PG8_BAR; PG8_MMA(1, 1, At, B1); PG8_BAR;
            PG8_LDB(B0, 1, 0); PG8_SCHED; PG8_LDA(At, 1, 0); PG8_STAGE(PG8_SA(0, 1), a2 + hstep, voffA);
            PG8_WAIT_L(8); PG8_BAR; PG8_WAIT_L(0); PG8_MMA(0, 0, At, B0); PG8_BAR; PG8_SCHED;
            PG8_LDB(B1, 1, 1); PG8_STAGE(PG8_SB(1, 0), b3, voffB);
            PG8_BAR; PG8_WAIT_L(0); PG8_MMA(0, 1, At, B1); PG8_BAR;
            PG8_LDA(At, 1, 1); PG8_STAGE(PG8_SA(1, 0), a3, voffA);
            PG8_BAR; PG8_WAIT_L(0); PG8_MMA(1, 0, At, B0); PG8_BAR; PG8_SCHED;
            PG8_STAGE(PG8_SB(1, 1), b3 + hstep, voffB);
            PG8_WAIT_V(6); PG8_BAR; PG8_MMA(1, 1, At, B1); PG8_BAR;
            }
        }
        if constexpr (ALIGN_EPI) { if (wr == 0) PG8_BAR; }
        if constexpr (!Epi::AFTER_DRAIN) { E(acc, cur, wr, wc, fr, fq); S.done(cur); }
        if (!has_next) break;
#pragma unroll
        for (int a = 0; a < 2; ++a)
#pragma unroll
            for (int b = 0; b < 2; ++b)
#pragma unroll
                for (int m = 0; m < 4; ++m)
#pragma unroll
                    for (int n = 0; n < 2; ++n) acc[a][b][m][n] = (f32x4){0.f, 0.f, 0.f, 0.f};
        cur = nxt; cA = nA; cB = nB; ++ui;
        if constexpr (ALIGN_EPI) { if (wr == 1) PG8_BAR; }
    }
    PG8_WAIT_V(0);
    if constexpr (!ALIGN_EPI) { if (wr == 0) PG8_BAR; }
    PG8_BAR;
    if constexpr (Epi::AFTER_DRAIN) { E.fused(acc, cur, wr, wc, fr, fq, lds, wid, lane); S.done(cur); }
#undef PG8_SA
#undef PG8_SB
#undef PG8_STAGE
#undef PG8_LDA
#undef PG8_LDB
#undef PG8_MMA
#undef PG8_WAIT_V
#undef PG8_WAIT_L
#undef PG8_BAR
#undef PG8_SCHED
}
}
constexpr int NWAVES = 8;
constexpr int NB = 2, SEQ = 4096, DM = 2048, NL = 4, MTOK = NB * SEQ, DIN = 5296, DFF = 8192, MODW = 6 * DM;
constexpr int ZP = 5376;
constexpr int Z_FQ = 0, Z_FK = 768, Z_FV = 1536, Z_NQ = 2304, Z_KC = 3072, Z_VC = 3264, Z_KS = 3456, Z_VS = 3648, Z_KW = 3840, Z_VW = 4032, Z_FF = 4224, Z_NG = 4236, Z_CU = 4352;
__host__ __device__ constexpr int zsrc(int n) {
    return n < 2304 ? n : n < 3072 ? 2316 + (n - 2304) : n < 4224 ? 3084 + (n - 3072) : n < 4236 ? 2304 + (n - 4224) : n < 4272 ? n : n < 4352 ? -1 : (((n - 4352) & 255) < 128 ? 4272 + 128 * ((n - 4352) >> 8) + ((n - 4352) & 127) : 4784 + 128 * ((n - 4352) >> 8) + ((n - 4352) & 127));
}
constexpr int Z_GLU_TILE0 = 17;
constexpr unsigned Z_QTILES = 0xE07u;
constexpr float LOG2E = 1.4426950408889634f;
constexpr float QSCALE = 0.125f * LOG2E;
constexpr float RMS_EPS = 1e-6f;
constexpr int PH_PRO = 0, PH_FIN = 1, PH_L0 = 2, PH_PER_LAYER = 8, PH_FINAL = PH_L0 + NL * PH_PER_LAYER, NPH = PH_FINAL + 1;
enum { LP_NORM1 = 0, LP_GIN = 1, LP_PRE = 2, LP_ATTN = 3, LP_GOUT = 4, LP_NORM2 = 5, LP_G1 = 6, LP_G2 = 7 };
constexpr size_t MiB = 1u << 20;
constexpr size_t WS_CTL = 0, CTL_ZERO_BYTES = 1 * MiB;
constexpr size_t WS_WIN = 1 * MiB, WS_WOUT = 85 * MiB, WS_W1 = 117 * MiB, WS_W2 = 245 * MiB;
constexpr size_t WS_MODP = 373 * MiB, WS_MOD = 379 * MiB, WS_LUT = 380 * MiB, WS_WCT = 381 * MiB;
constexpr size_t WS_X = 384 * MiB, WS_XN = 448 * MiB, WS_Z = 480 * MiB, WS_MIX = 564 * MiB, WS_HB = 596 * MiB;
constexpr size_t WS_F2 = 724 * MiB, WS_KCMP = 725 * MiB, WS_VCMP = 725 * MiB + 256 * 1024;
constexpr size_t WS_DBG = 728 * MiB;
constexpr size_t WS_END = 760 * MiB;
static_assert((size_t)NL * ZP * DM * 2 == 84 * MiB && (size_t)MTOK * ZP * 2 == 84 * MiB && (size_t)MTOK * DFF * 2 == 128 * MiB, "ws map");
constexpr int MOD_KCH = 16;
constexpr int CW_TMO = 0, CW_CODE = 1, CW_BAR = 4096, CW_Q = 8192;
constexpr int RING_OFF = 0, RING_BYTES = 144384, LDSCTL_OFF = RING_BYTES, MISC_OFF = LDSCTL_OFF + 320, LDS_BYTES = 147456;

#define GAS __attribute__((address_space(1)))
#define LAS __attribute__((address_space(3)))
typedef unsigned short bf16;
typedef unsigned v4u __attribute__((ext_vector_type(4)));
typedef unsigned v2u __attribute__((ext_vector_type(2)));
typedef float f32x4 __attribute__((ext_vector_type(4)));
typedef float f32x16 __attribute__((ext_vector_type(16)));
typedef short bf16x8 __attribute__((ext_vector_type(8)));
typedef short s16x4 __attribute__((ext_vector_type(4)));
typedef GAS unsigned gu32;
#define RLX_AGENT __ATOMIC_RELAXED, __HIP_MEMORY_SCOPE_AGENT
#define LDS_WAIT() asm volatile("s_waitcnt lgkmcnt(0)" ::: "memory")
#define VM_WAIT() asm volatile("s_waitcnt vmcnt(0)" ::: "memory")
__device__ __forceinline__ unsigned pk2(float lo, float hi) { unsigned r; asm volatile("v_cvt_pk_bf16_f32 %0, %1, %2" : "=v"(r) : "v"(lo), "v"(hi)); return r; }
__device__ __forceinline__ float bf_lo(unsigned w) { return __uint_as_float(w << 16); }
__device__ __forceinline__ float bf_hi(unsigned w) { return __uint_as_float(w & 0xffff0000u); }
__device__ __forceinline__ float bf1(bf16 h) { return __uint_as_float((unsigned)h << 16); }
__device__ __forceinline__ float sigm(float x) { return 1.f / (1.f + __expf(-x)); }
__device__ __forceinline__ float wave_sum(float v) {
#pragma unroll
    for (int o = 1; o < 64; o <<= 1) v += __shfl_xor(v, o);
    return v;
}
__device__ __forceinline__ int t5_bucket(int dist) {
    int n = dist > 0 ? dist : 0;
    if (n < 16) return n;
    int large = 16 + (int)(logf((float)n / 16.0f) / 2.0794415416798357f * 16.0f);
    return large < 31 ? large : 31;
}
#define XB_TMO      128
#define XB_XCNT(j)  (256  + 64 * (j))
#define XB_XSUB(j)  (1280 + 64 * (j))
#define XB_XGEN(j)  (2304 + 64 * (j))
#define XB_TOP      3328
#define XB_TOPGEN   3392
#define XCD_BAR_WORDS 3456
#define XB_SPIN_CAP (1u << 18)

__device__ __forceinline__ unsigned xb_ld(unsigned* p)              { return __hip_atomic_load(p, __ATOMIC_RELAXED, __HIP_MEMORY_SCOPE_AGENT); }
__device__ __forceinline__ unsigned xb_add(unsigned* p, unsigned v) { return __hip_atomic_fetch_add(p, v, __ATOMIC_RELAXED, __HIP_MEMORY_SCOPE_AGENT); }
__device__ __forceinline__ unsigned xb_xcc_id() { return (unsigned)__builtin_amdgcn_s_getreg((3 << 11) | 20) & 0xFu; }
#define XB_SPIN(cond, bar) do { unsigned _sp = 0; while (cond) { __builtin_amdgcn_s_sleep(1); \
    if ((++_sp & 255u) == 0u) { if (xb_ld(&(bar)[XB_TMO])) break; if (_sp > XB_SPIN_CAP) { atomicAdd(&(bar)[XB_TMO], 1u); break; } } } } while (0)

struct XcdBarrier {
    unsigned* bar; unsigned x;
    volatile LAS unsigned* st;
};

__device__ __forceinline__ XcdBarrier xcd_barrier_post(unsigned* bar, volatile LAS unsigned* st) {
    XcdBarrier b; b.bar = bar; b.x = xb_xcc_id(); b.st = st;
    if (threadIdx.x == 0) (void)xb_add(&bar[XB_XCNT(b.x)], 1u);
    return b;
}
__device__ __forceinline__ void xcd_barrier_complete(unsigned* bar, unsigned x, unsigned& nloc, unsigned& nx) {
    const unsigned G = gridDim.x * gridDim.y * gridDim.z;
    unsigned sum, cnt, mine, sp = 0u;
    for (;;) {
        sum = 0u; cnt = 0u; mine = 0u;
#pragma unroll
        for (unsigned j = 0; j < 16; ++j) { const unsigned c = xb_ld(&bar[XB_XCNT(j)]); sum += c; cnt += (c > 0u) ? 1u : 0u; mine = (j == x) ? c : mine; }
        if (sum == G) break;
        __builtin_amdgcn_s_sleep(1);
        if ((++sp & 255u) == 0u) { if (xb_ld(&bar[XB_TMO])) break; if (sp > XB_SPIN_CAP) { atomicAdd(&bar[XB_TMO], 1u); break; } }
    }
    nloc = mine > 0u ? mine : 1u; nx = cnt > 0u ? cnt : 1u;
}

__device__ __forceinline__ void xcd_barrier(const XcdBarrier& b) {
    asm volatile("s_waitcnt vmcnt(0)" ::: "memory");
    __syncthreads();
    if (threadIdx.x == 0) {
        unsigned* bar = b.bar; unsigned bx_ = b.x;
        asm volatile("" : "+s"(bar), "+s"(bx_));
        __builtin_amdgcn_s_waitcnt(0);
        unsigned nloc = b.st[0], nx = b.st[1];
        if (nloc == 0u) { xcd_barrier_complete(bar, bx_, nloc, nx); b.st[0] = nloc; b.st[1] = nx; }
        const unsigned old = xb_add(&bar[XB_XSUB(bx_)], 1u);
        const unsigned gen = old / nloc;
        if (old + 1u == (gen + 1u) * nloc) {
            __builtin_amdgcn_fence(__ATOMIC_RELEASE, "agent");
            asm volatile("s_waitcnt vmcnt(0)" ::: "memory");
            const unsigned og = xb_add(&bar[XB_TOP], 1u);
            const unsigned tg = og / nx;
            if (og + 1u == (tg + 1u) * nx) xb_add(&bar[XB_TOPGEN], 1u);
            else XB_SPIN(xb_ld(&bar[XB_TOPGEN]) == tg, bar);
            __builtin_amdgcn_fence(__ATOMIC_ACQUIRE, "agent");
            xb_add(&bar[XB_XGEN(bx_)], 1u);
            asm volatile("s_waitcnt vmcnt(0)" ::: "memory");
        } else {
            XB_SPIN(xb_ld(&bar[XB_XGEN(bx_)]) == gen, bar);
            __builtin_amdgcn_fence(__ATOMIC_ACQUIRE, "agent");
            asm volatile("s_waitcnt vmcnt(0)" ::: "memory");
        }
    }
    __syncthreads();
}
struct Frame {
    LAS unsigned char* lds;
    volatile LAS unsigned* MISC;
    gu32* ctl;
    int tid, lane, wave, gw, ngw;
    unsigned char* ws;
};
struct Args { const float* in[20]; float* out; unsigned char* ws; int ph_lo, ph_hi, flags, pad; };
typedef const __attribute__((address_space(4))) Args* KA;
__device__ __forceinline__ KA kargs() { KA p = (KA)__builtin_amdgcn_kernarg_segment_ptr(); asm volatile("" : "+s"(p)); return p; }
enum { IN_X = 0, IN_C, IN_WMOD, IN_BMOD, IN_N1G, IN_WIN, IN_BF, IN_WCK, IN_WCV, IN_POS, IN_CW, IN_CB, IN_CLG, IN_CLB, IN_WOUT, IN_N2G, IN_W1, IN_W2, IN_RELB, IN_FING };
enum { FL_FOX = 1, FL_NSA = 2, FL_PRE = 4 };

template <bool PERM> __device__ __forceinline__ void tr_item(const float* W, int K, int N, bf16* WT, LAS float* scr, int kb, int nb, int lane) {
    const int k0 = 64 * kb, n0 = 32 * nb; const int nd = n0 + (lane & 31); const int sc = PERM ? zsrc(nd) : nd;
    const float* src = W + (size_t)(k0 + (lane >> 5)) * N + (sc >= 0 ? sc : 0);
    float v[32];
#pragma unroll
    for (int i = 0; i < 32; ++i) v[i] = src[(size_t)(2 * i) * N];
#pragma unroll
    for (int i = 0; i < 32; ++i) scr[(2 * i + (lane >> 5)) * 33 + (lane & 31)] = sc >= 0 ? v[i] : 0.f;
    LDS_WAIT(); asm volatile("" ::: "memory");
    const int c = lane & 7;
#pragma unroll
    for (int j = 0; j < 4; ++j) { const int n = (lane >> 3) + 8 * j; const LAS float* s = scr + (8 * c) * 33 + n;
        v4u o; o.x = pk2(s[0 * 33], s[1 * 33]); o.y = pk2(s[2 * 33], s[3 * 33]); o.z = pk2(s[4 * 33], s[5 * 33]); o.w = pk2(s[6 * 33], s[7 * 33]);
        *(GAS v4u*)(WT + (size_t)(n0 + n) * K + k0 + 8 * c) = o; }
    LDS_WAIT(); asm volatile("" ::: "memory");
}
constexpr int IT_MOD = NL * 48 * MOD_KCH;
constexpr int IT_TIN = (DM / 64) * (ZP / 32), IT_TOUT = (DM / 64) * (DM / 32), IT_T1 = (DM / 64) * (DFF / 32), IT_T2 = (DFF / 64) * (DM / 32), IT_TL = IT_TIN + IT_TOUT + IT_T1 + IT_T2;
constexpr int IT_WCT = NL * 2 * 32, IT_TOTAL = IT_MOD + NL * IT_TL + IT_WCT + 1;
constexpr int PRO_CACT_OFF = 8 * 8448;

__device__ __forceinline__ void p_prologue(Frame& F, KA A) {
    LAS float* scr = (LAS float*)(F.lds + RING_OFF + F.wave * 8448);
    LAS float* cact = (LAS float*)(F.lds + RING_OFF + PRO_CACT_OFF);
    for (int i = F.tid; i < 2 * DM; i += NWAVES * 64) { const float v = A->in[IN_C][i]; cact[i] = v * sigm(v); }
    LDS_WAIT(); __syncthreads();
    bf16* WIN = (bf16*)(F.ws + WS_WIN); bf16* WOUT = (bf16*)(F.ws + WS_WOUT); bf16* W1 = (bf16*)(F.ws + WS_W1); bf16* W2 = (bf16*)(F.ws + WS_W2);
    float* MODP = (float*)(F.ws + WS_MODP);
    for (int it = F.gw; it < IT_TOTAL; it += F.ngw) {
        int r = it;
        if (r < IT_MOD) {
            const int kc = r % MOD_KCH, cg = (r / MOD_KCH) % 48, l = r / (MOD_KCH * 48); constexpr int KCL = DM / MOD_KCH;
            const float* w = A->in[IN_WMOD] + ((size_t)l * DM + KCL * kc) * MODW + 256 * cg + 4 * F.lane;
            f32x4 a0 = {0.f, 0.f, 0.f, 0.f}, a1 = {0.f, 0.f, 0.f, 0.f};
#pragma unroll 16
            for (int k = 0; k < KCL; ++k) { const f32x4 wv = *(const GAS f32x4*)(w + (size_t)k * MODW); a0 += wv * cact[KCL * kc + k]; a1 += wv * cact[DM + KCL * kc + k]; }
            *(GAS f32x4*)(MODP + ((size_t)(kc * NL + l) * 2 + 0) * MODW + 256 * cg + 4 * F.lane) = a0;
            *(GAS f32x4*)(MODP + ((size_t)(kc * NL + l) * 2 + 1) * MODW + 256 * cg + 4 * F.lane) = a1;
            continue; }
        r -= IT_MOD;
        if (r < NL * IT_TL) { const int l = r / IT_TL; r %= IT_TL;
            if (r < IT_TIN) { tr_item<true>(A->in[IN_WIN] + (size_t)l * DM * DIN, DM, DIN, WIN + (size_t)l * ZP * DM, scr, r / (ZP / 32), r % (ZP / 32), F.lane); continue; } r -= IT_TIN;
            if (r < IT_TOUT) { tr_item<false>(A->in[IN_WOUT] + (size_t)l * DM * DM, DM, DM, WOUT + (size_t)l * DM * DM, scr, r / (DM / 32), r % (DM / 32), F.lane); continue; } r -= IT_TOUT;
            if (r < IT_T1) { tr_item<false>(A->in[IN_W1] + (size_t)l * DM * DFF, DM, DFF, W1 + (size_t)l * DFF * DM, scr, r / (DFF / 32), r % (DFF / 32), F.lane); continue; } r -= IT_T1;
            tr_item<false>(A->in[IN_W2] + (size_t)l * DFF * DM, DFF, DM, W2 + (size_t)l * DM * DFF, scr, r / (DM / 32), r % (DM / 32), F.lane); continue; }
        r -= NL * IT_TL;
        if (r < IT_WCT) {
            const int lp = r % 32, kv = (r / 32) & 1, l = r / 64;
            const float* w = A->in[kv ? IN_WCV : IN_WCK] + ((size_t)(l * 32 + lp) * 64) * 64 + F.lane;
            bf16* o = (bf16*)(F.ws + WS_WCT) + ((size_t)((l * 2 + kv) * 32 + lp) * 64 + F.lane) * 64;
#pragma unroll
            for (int d8 = 0; d8 < 8; ++d8) { float x[8];
#pragma unroll
                for (int i = 0; i < 8; ++i) x[i] = w[(size_t)(8 * d8 + i) * 64];
                v4u q; q.x = pk2(x[0], x[1]); q.y = pk2(x[2], x[3]); q.z = pk2(x[4], x[5]); q.w = pk2(x[6], x[7]);
                *(GAS v4u*)(o + 8 * d8) = q; }
            continue; }
        {
            float* LUT = (float*)(F.ws + WS_LUT);
            for (int i = F.lane; i < 12 * 128; i += 64) { const int h = i / 128, d = i % 128; LUT[i] = A->in[IN_RELB][t5_bucket(d) * 12 + h] * LOG2E; }
        }
    }
}
__device__ __forceinline__ void p_modfin(Frame& F, KA A) {
    const float* MODP = (const float*)(F.ws + WS_MODP); float* MOD = (float*)(F.ws + WS_MOD);
    for (int i = F.gw * 64 + F.lane; i < NL * 2 * MODW; i += F.ngw * 64) { const int j = i % MODW, l = i / (2 * MODW);
        float s = A->in[IN_BMOD][l * MODW + j];
#pragma unroll
        for (int kc = 0; kc < MOD_KCH; ++kc) s += MODP[(size_t)kc * NL * 2 * MODW + i];
        MOD[i] = s; }
}
__device__ __forceinline__ void p_norm(Frame& F, const float* xin, const float* gain, const float* modl, int sh_off, int sc_off, bf16* XN) {
    for (int row = F.gw; row < MTOK; row += F.ngw) { const int b = row / SEQ;
        const GAS f32x4* xr = (const GAS f32x4*)(xin + (size_t)row * DM) + F.lane;
        f32x4 v[8]; float ss = 0.f;
#pragma unroll
        for (int j = 0; j < 8; ++j) { v[j] = xr[64 * j]; ss += (v[j].x * v[j].x + v[j].y * v[j].y) + (v[j].z * v[j].z + v[j].w * v[j].w); }
        const float rs = rsqrtf(wave_sum(ss) * (1.f / DM) + RMS_EPS);
        const float* mb = modl + (size_t)b * MODW;
        GAS v2u* o8 = (GAS v2u*)(XN + (size_t)row * DM) + F.lane;
#pragma unroll
        for (int j = 0; j < 8; ++j) { const int col = 4 * (F.lane + 64 * j);
            const f32x4 g4 = *(const GAS f32x4*)(gain + col), sc4 = *(const GAS f32x4*)(mb + sc_off + col), sh4 = *(const GAS f32x4*)(mb + sh_off + col);
            const f32x4 y = v[j] * rs * g4 * (sc4 + 1.f) + sh4;
            v2u w; w.x = pk2(y.x, y.y); w.y = pk2(y.z, y.w); o8[64 * j] = w; }
    }
}
__device__ __forceinline__ void p_final(Frame& F, const float* xin, const float* gain, float* out) {
    for (int row = F.gw; row < MTOK; row += F.ngw) {
        const GAS f32x4* xr = (const GAS f32x4*)(xin + (size_t)row * DM) + F.lane;
        f32x4 v[8]; float ss = 0.f;
#pragma unroll
        for (int j = 0; j < 8; ++j) { v[j] = xr[64 * j]; ss += (v[j].x * v[j].x + v[j].y * v[j].y) + (v[j].z * v[j].z + v[j].w * v[j].w); }
        const float rs = rsqrtf(wave_sum(ss) * (1.f / DM) + RMS_EPS);
        GAS f32x4* o = (GAS f32x4*)(out + (size_t)row * DM) + F.lane;
#pragma unroll
        for (int j = 0; j < 8; ++j) { const f32x4 g4 = *(const GAS f32x4*)(gain + 4 * (F.lane + 64 * j)); o[64 * j] = v[j] * rs * g4; }
    }
}
__device__ __forceinline__ void pre_compress_unit(Frame& F, KA A, int l, int u) {
    const int kv = u & 1, mt = (u >> 1) & 7, bg = u >> 4, b = bg / 3, g = bg % 3;
    const int w = F.wave, nb = w & 1, part = (w >> 1) & 1, kh = w >> 2, m = F.lane & 31, hi = F.lane >> 5;
    const int mb = 32 * mt + m + part;
    const bf16* Z = (const bf16*)(F.ws + WS_Z);
    const bf16* zp = Z + (size_t)(b * SEQ + 16 * (mb < 256 ? mb : 0)) * ZP + (kv ? Z_VC : Z_KC) + g * 64 + 8 * hi;
    const float* posp = A->in[IN_POS] + (size_t)l * 32 * 64 + (16 * part) * 64 + 8 * hi;
    const bf16* wt = (const bf16*)(F.ws + WS_WCT) + ((size_t)((l * 2 + kv) * 32 + 16 * part) * 64 + 32 * nb + m) * 64 + 8 * hi;
    f32x16 acc = {};
    for (int ll = 8 * kh; ll < 8 * kh + 8; ++ll) {
#pragma unroll
        for (int d0 = 0; d0 < 64; d0 += 16) {
            v4u az = *(const GAS v4u*)(zp + (size_t)ll * ZP + d0); if (mb >= 256) az = (v4u){0u, 0u, 0u, 0u};
            const f32x4 p0 = *(const GAS f32x4*)(posp + ll * 64 + d0), p1 = *(const GAS f32x4*)(posp + ll * 64 + d0 + 4);
            v4u aw; aw.x = pk2(bf_lo(az.x) + p0.x, bf_hi(az.x) + p0.y); aw.y = pk2(bf_lo(az.y) + p0.z, bf_hi(az.y) + p0.w);
            aw.z = pk2(bf_lo(az.z) + p1.x, bf_hi(az.z) + p1.y); aw.w = pk2(bf_lo(az.w) + p1.z, bf_hi(az.w) + p1.w);
            const v4u bw = *(const GAS v4u*)(wt + (size_t)ll * 64 * 64 + d0);
            acc = __builtin_amdgcn_mfma_f32_32x32x16_bf16(__builtin_bit_cast(bf16x8, aw), __builtin_bit_cast(bf16x8, bw), acc, 0, 0, 0);
        }
    }
    LAS float* red = (LAS float*)(F.lds + RING_OFF);
#pragma unroll
    for (int r = 0; r < 16; ++r) { const int mloc = (r & 3) + 8 * (r >> 2) + 4 * hi; red[w * 1024 + mloc * 32 + m] = acc[r]; }
    LDS_WAIT(); __syncthreads();
    { const int mloc = F.tid >> 4, e4 = (F.tid & 15) * 4, nb2 = e4 >> 5, el = e4 & 31;
      f32x4 s = {0.f, 0.f, 0.f, 0.f};
#pragma unroll
      for (int q = 0; q < 4; ++q) s += *(const LAS f32x4*)(red + (nb2 + 2 * q) * 1024 + mloc * 32 + el);
      bf16* dst = (bf16*)(F.ws + (kv ? WS_VCMP : WS_KCMP)) + ((size_t)(b * 3 + g) * 256 + 32 * mt + mloc) * 64 + e4;
      v2u o; o.x = pk2(s.x, s.y); o.y = pk2(s.z, s.w); *(GAS v2u*)dst = o; }
    LDS_WAIT(); __syncthreads();
}
__device__ __forceinline__ float logsig(float x) { return x >= 0.f ? -log1pf(expf(-x)) : x - log1pf(expf(x)); }
__device__ __forceinline__ float logsig_fast(float x) { const float e = __expf(-fabsf(x)); return fminf(x, 0.f) - __logf(1.f + e); }
__device__ __forceinline__ void pre_cumsum(Frame& F, KA A, int l, int b) {
    const bf16* Z = (const bf16*)(F.ws + WS_Z); float* NF2 = (float*)(F.ws + WS_F2);
    const float* bfp = A->in[IN_BF] + l * 12;
    float bfv[12], run[12];
#pragma unroll
    for (int h = 0; h < 12; ++h) { bfv[h] = bfp[h]; run[h] = 0.f; }
    const int t0 = F.tid * 8;
#pragma unroll
    for (int i = 0; i < 8; ++i) { const GAS v2u* p = (const GAS v2u*)(Z + (size_t)(b * SEQ + t0 + i) * ZP + Z_FF); const v2u a = p[0], c = p[1], d = p[2];
        const unsigned wv[6] = {a.x, a.y, c.x, c.y, d.x, d.y};
#pragma unroll
        for (int h2 = 0; h2 < 6; ++h2) { run[2 * h2] += logsig_fast(bf_lo(wv[h2]) + bfv[2 * h2]); run[2 * h2 + 1] += logsig_fast(bf_hi(wv[h2]) + bfv[2 * h2 + 1]); } }
    LAS float* wt = (LAS float*)(F.lds + RING_OFF + 40960);
    float off[12];
#pragma unroll
    for (int h = 0; h < 12; ++h) { float v = run[h];
#pragma unroll
        for (int o = 1; o < 64; o <<= 1) { const float n = __shfl_up(v, o); if (F.lane >= o) v += n; }
        if (F.lane == 63) wt[F.wave * 12 + h] = v;
        off[h] = v - run[h]; }
    LDS_WAIT(); __syncthreads();
#pragma unroll
    for (int h = 0; h < 12; ++h) { float s = 0.f; for (int w2 = 0; w2 < F.wave; ++w2) s += wt[w2 * 12 + h]; off[h] += s; }
#pragma unroll
    for (int i = 0; i < 8; ++i) { const GAS v2u* p = (const GAS v2u*)(Z + (size_t)(b * SEQ + t0 + i) * ZP + Z_FF); const v2u a = p[0], c = p[1], d = p[2];
        const unsigned wv[6] = {a.x, a.y, c.x, c.y, d.x, d.y};
#pragma unroll
        for (int h2 = 0; h2 < 6; ++h2) { off[2 * h2] += logsig_fast(bf_lo(wv[h2]) + bfv[2 * h2]); off[2 * h2 + 1] += logsig_fast(bf_hi(wv[h2]) + bfv[2 * h2 + 1]);
            NF2[(size_t)(b * 12 + 2 * h2) * SEQ + t0 + i] = -LOG2E * off[2 * h2]; NF2[(size_t)(b * 12 + 2 * h2 + 1) * SEQ + t0 + i] = -LOG2E * off[2 * h2 + 1]; } }
    LDS_WAIT(); __syncthreads();
}
constexpr int CONV_W_OFF = 49152, CONV_TOK = 4;
__device__ __forceinline__ void pre_conv(Frame& F, KA A, int l, int w0, int nw) {
    const bf16* Z = (const bf16*)(F.ws + WS_Z); bf16* MIX = (bf16*)(F.ws + WS_MIX);
    LAS float* cw = (LAS float*)(F.lds + RING_OFF + CONV_W_OFF);
    if (w0 < 0) return;
    { const GAS f32x4* src = (const GAS f32x4*)(A->in[IN_CW] + (size_t)l * 31 * 512); f32x4 tmp[8];
#pragma unroll
      for (int q = 0; q < 8; ++q) { const int i = F.tid + q * NWAVES * 64; if (i < 31 * 512 / 4) tmp[q] = src[i]; }
#pragma unroll
      for (int q = 0; q < 8; ++q) { const int i = F.tid + q * NWAVES * 64; if (i < 31 * 512 / 4) ((LAS f32x4*)cw)[i] = tmp[q]; } }
    LDS_WAIT(); __syncthreads();
    const int c0 = 8 * F.lane;
    float cb[8], lg[8], lb[8];
#pragma unroll
    for (int i = 0; i < 8; ++i) { cb[i] = A->in[IN_CB][l * 512 + c0 + i]; lg[i] = A->in[IN_CLG][l * 512 + c0 + i]; lb[i] = A->in[IN_CLB][l * 512 + c0 + i]; }
    for (int it = w0; it < MTOK / CONV_TOK; it += nw) {
        const int b = it / (SEQ / CONV_TOK), t1 = (it % (SEQ / CONV_TOK)) * CONV_TOK;
        float acc[CONV_TOK][8]; f32x4 wl[CONV_TOK][2];
#pragma unroll
        for (int o = 0; o < CONV_TOK; ++o)
#pragma unroll
            for (int i = 0; i < 8; ++i) acc[o][i] = 0.f;
        const bf16* zr = Z + ((ptrdiff_t)(b * SEQ + t1) - 30) * ZP + Z_CU + 256 * (F.lane >> 4) + 8 * (F.lane & 15);
        int tin = t1 - 30; const LAS float* cwj = cw + c0;
#define CONV_STEP(JM, LDW, OLO, OHI) do { \
            const v4u uv = *(const GAS v4u*)(zr); \
            if (LDW) { wl[(JM) & 3][0] = *(const LAS f32x4*)(cwj); wl[(JM) & 3][1] = *(const LAS f32x4*)(cwj + 4); } \
            const bool ok = tin >= 0; float u[8]; \
            u[0] = ok ? bf_lo(uv.x) : 0.f; u[1] = ok ? bf_hi(uv.x) : 0.f; u[2] = ok ? bf_lo(uv.y) : 0.f; u[3] = ok ? bf_hi(uv.y) : 0.f; \
            u[4] = ok ? bf_lo(uv.z) : 0.f; u[5] = ok ? bf_hi(uv.z) : 0.f; u[6] = ok ? bf_lo(uv.w) : 0.f; u[7] = ok ? bf_hi(uv.w) : 0.f; \
            _Pragma("unroll") for (int o = (OLO); o <= (OHI); ++o) { const f32x4 w0_ = wl[((JM) - o) & 3][0], w1_ = wl[((JM) - o) & 3][1]; \
                acc[o][0] += w0_.x * u[0]; acc[o][1] += w0_.y * u[1]; acc[o][2] += w0_.z * u[2]; acc[o][3] += w0_.w * u[3]; \
                acc[o][4] += w1_.x * u[4]; acc[o][5] += w1_.y * u[5]; acc[o][6] += w1_.z * u[6]; acc[o][7] += w1_.w * u[7]; } \
            zr += ZP; ++tin; cwj += 512; } while (0)
        CONV_STEP(0, true, 0, 0); CONV_STEP(1, true, 0, 1); CONV_STEP(2, true, 0, 2);
        for (int jj = 0; jj < 7; ++jj) { CONV_STEP(3, true, 0, 3); CONV_STEP(4, true, 0, 3); CONV_STEP(5, true, 0, 3); CONV_STEP(6, true, 0, 3); }
        CONV_STEP(31, false, 1, 3); CONV_STEP(32, false, 2, 3); CONV_STEP(33, false, 3, 3);
#undef CONV_STEP
#pragma unroll
        for (int o = 0; o < CONV_TOK; ++o) { float s_ = 0.f;
#pragma unroll
            for (int i = 0; i < 8; ++i) { acc[o][i] += cb[i]; s_ += acc[o][i]; }
            const float mu = wave_sum(s_) * (1.f / 512.f); float q = 0.f;
#pragma unroll
            for (int i = 0; i < 8; ++i) { acc[o][i] -= mu; q += acc[o][i] * acc[o][i]; }
            const float rstd = rsqrtf(wave_sum(q) * (1.f / 512.f) + RMS_EPS);
            float y[8];
#pragma unroll
            for (int i = 0; i < 8; ++i) { const float yn = acc[o][i] * rstd * lg[i] + lb[i]; y[i] = yn * sigm(yn); }
            v4u w; w.x = pk2(y[0], y[1]); w.y = pk2(y[2], y[3]); w.z = pk2(y[4], y[5]); w.w = pk2(y[6], y[7]);
            *(GAS v4u*)(MIX + (size_t)(b * SEQ + t1 + o) * DM + 1536 + c0) = w; }
    }
}
__device__ __forceinline__ void p_pre(Frame& F, KA A, int l) {
    const int G = (int)gridDim.x, bx = (int)blockIdx.x;
    for (int u = bx; u < 98; u += G) { if (u < 96) pre_compress_unit(F, A, l, u); else pre_cumsum(F, A, l, u - 96); }
    if (G > 128) { if (bx >= 98) pre_conv(F, A, l, (bx - 98) * NWAVES + F.wave, (G - 98) * NWAVES); }
    else pre_conv(F, A, l, F.gw, F.ngw);
}
namespace fxf {
using u32x4=__attribute__((ext_vector_type(4)))unsigned;
constexpr int NW=8,QBLK=32,QB=QBLK*NW,KVBLK=64;
__device__ __forceinline__ int crow(int r,int hi){return (r&3)+8*(r>>2)+4*hi;}
#define SBAR() __builtin_amdgcn_sched_barrier(0)
__device__ __forceinline__ void cmask(f32x16&p0,f32x16&p1,int jb,int qrel,int hi){
  const float NEG=-INFINITY; int kb=64*jb+4*hi;
  #pragma unroll
  for(int r=0;r<16;++r){int kv=kb+(r&3)+8*(r>>2); if(kv>qrel)p0[r]=NEG; if(kv+32>qrel)p1[r]=NEG;}
}

constexpr int NSLOT=3, SLOTB=8192;
constexpr int LDS_K=0, LDS_V=NSLOT*SLOTB, LDS_WS=2*NSLOT*SLOTB, LDS_OST=LDS_WS+NW*64*4, LDS_BYTES=LDS_OST+NW*4096, LDS_F=LDS_BYTES  , LDS_END=LDS_F+16384;
__device__ __forceinline__ void glds16(const void*gsrc,unsigned lds_dst){unsigned keep;
  asm volatile("s_mov_b32 %0, m0\n\ts_mov_b32 m0, %2\n\ts_nop 0\n\tglobal_load_lds_dwordx4 %1, off\n\ts_mov_b32 m0, %0":"=&s"(keep):"v"(gsrc),"s"(lds_dst):"memory");}
__device__ __forceinline__ float max3f(float a,float b,float c){float r;asm("v_max3_f32 %0, %1, %2, %3":"=v"(r):"v"(a),"v"(b),"v"(c));return r;}
__device__ __forceinline__ float max2f(float a,float b){float r;asm("v_max_f32_e32 %0, %1, %2":"=v"(r):"v"(a),"v"(b));return r;}
__device__ __forceinline__ float fadd_s(float a,float b){float r;asm("v_add_f32_e32 %0, %1, %2":"=v"(r):"v"(a),"v"(b));return r;}
__device__ __forceinline__ float fsub_s(float a,float b){float r;asm("v_sub_f32_e32 %0, %1, %2":"=v"(r):"v"(a),"v"(b));return r;}
typedef float f32x2_t __attribute__((ext_vector_type(2))); typedef __bf16 bf16x2_t __attribute__((ext_vector_type(2)));
__device__ __forceinline__ unsigned cvtpk_s(float lo,float hi){f32x2_t v={lo,hi};bf16x2_t b=__builtin_convertvector(v,bf16x2_t);return __builtin_bit_cast(unsigned,b);}
#define WAIT_BAR(N) asm volatile("s_waitcnt vmcnt(" #N ") lgkmcnt(0)\n\ts_barrier":::"memory")

__device__ __forceinline__ void qkt(f32x16&p0,f32x16&p1,const char*Kslot,const bf16x8*qr,const f32x16&negm,int r32,int hi){
  const char*kb=Kslot+hi*1024+r32*16;
  #pragma unroll
  for(int d0=0;d0<4;++d0){
    const bf16x8 b0=*reinterpret_cast<const bf16x8*>(kb+d0*2048);
    const bf16x8 b1=*reinterpret_cast<const bf16x8*>(kb+d0*2048+512);
    if(d0==0){p0=__builtin_amdgcn_mfma_f32_32x32x16_bf16(b0,qr[0],negm,0,0,0);p1=__builtin_amdgcn_mfma_f32_32x32x16_bf16(b1,qr[0],negm,0,0,0);}
    else{p0=__builtin_amdgcn_mfma_f32_32x32x16_bf16(b0,qr[d0],p0,0,0,0);p1=__builtin_amdgcn_mfma_f32_32x32x16_bf16(b1,qr[d0],p1,0,0,0);}}
}
typedef __attribute__((address_space(3))) const char* lds_cptr;
typedef short v4i16_t __attribute__((ext_vector_type(4)));
__device__ __forceinline__ void kload8(bf16x8*kf,lds_cptr kp){
  kf[0]=*(const __attribute__((address_space(3))) bf16x8*)(kp);      kf[1]=*(const __attribute__((address_space(3))) bf16x8*)(kp+512);
  kf[2]=*(const __attribute__((address_space(3))) bf16x8*)(kp+2048); kf[3]=*(const __attribute__((address_space(3))) bf16x8*)(kp+2560);
  kf[4]=*(const __attribute__((address_space(3))) bf16x8*)(kp+4096); kf[5]=*(const __attribute__((address_space(3))) bf16x8*)(kp+4608);
  kf[6]=*(const __attribute__((address_space(3))) bf16x8*)(kp+6144); kf[7]=*(const __attribute__((address_space(3))) bf16x8*)(kp+6656);
}
__device__ __forceinline__ void kload2(bf16x8*kf,lds_cptr kp,int j){ kf[2*j]=*(const __attribute__((address_space(3))) bf16x8*)(kp+j*2048); kf[2*j+1]=*(const __attribute__((address_space(3))) bf16x8*)(kp+j*2048+512); }
__device__ __forceinline__ s16x4 vtr(lds_cptr p){ return __builtin_bit_cast(s16x4,__builtin_amdgcn_ds_read_tr16_b64_v4i16((__attribute__((address_space(3))) v4i16_t*)p)); }
__device__ __forceinline__ float rowmax(const f32x16&p0,const f32x16&p1){
  float a=max3f(p0[0],p0[1],p1[0]),b=max3f(p0[2],p0[3],p1[1]);a=max3f(a,p1[2],p1[3]);
  #pragma unroll
  for(int r=4;r<16;r+=4){a=max3f(a,p0[r],p0[r+1]);b=max3f(b,p0[r+2],p0[r+3]);a=max3f(a,p1[r],p1[r+1]);b=max3f(b,p1[r+2],p1[r+3]);}
  const float m=max2f(a,b);
  auto rr=__builtin_amdgcn_permlane32_swap(__float_as_uint(m),__float_as_uint(m),false,false);
  return max2f(__uint_as_float(rr[0]),__uint_as_float(rr[1]));
}
__device__ __forceinline__ void pv(f32x16*o,int vb,bf16x8 pa0,bf16x8 pa1,bf16x8 pa2,bf16x8 pa3){
  #pragma unroll
  for(int d0=0;d0<2;++d0){s16x4 lo[4],hi[4];
    #pragma unroll
    for(int ks=0;ks<4;++ks){
      asm volatile("ds_read_b64_tr_b16 %0,%1 offset:%c2":"=&v"(lo[ks]):"v"(vb),"i"(d0*4096+ks*1024):"memory");
      asm volatile("ds_read_b64_tr_b16 %0,%1 offset:%c2":"=&v"(hi[ks]):"v"(vb),"i"(d0*4096+ks*1024+512):"memory");}
    asm volatile("s_waitcnt lgkmcnt(0)":::"memory");SBAR();
    #define PK(k) (bf16x8){lo[k][0],lo[k][1],lo[k][2],lo[k][3],hi[k][0],hi[k][1],hi[k][2],hi[k][3]}
    o[d0]=__builtin_amdgcn_mfma_f32_32x32x16_bf16(pa0,PK(0),o[d0],0,0,0);
    o[d0]=__builtin_amdgcn_mfma_f32_32x32x16_bf16(pa1,PK(1),o[d0],0,0,0);
    o[d0]=__builtin_amdgcn_mfma_f32_32x32x16_bf16(pa2,PK(2),o[d0],0,0,0);
    o[d0]=__builtin_amdgcn_mfma_f32_32x32x16_bf16(pa3,PK(3),o[d0],0,0,0);
    #undef PK
  }
}

#ifndef ATTN_STORE16
#define ATTN_STORE16(p,v) (*(u32x4*)(p)=(v))
#endif
template<int THRL,int DMQ,int DMK,int DMO> __device__ __forceinline__ void attn_unit(int tid_,int q0,const bf16*Qu,const bf16*__restrict__ Kh,const bf16*__restrict__ Vh,bf16*Ou,char*shm){
  const int tid=tid_,lane=tid&63,r32=lane&31,hi=lane>>5; const int wid=__builtin_amdgcn_readfirstlane(tid>>6);
  const bf16*Qw=Qu+(long)(wid*QBLK)*DMQ;
  const __attribute__((address_space(3))) float* fbL=(const __attribute__((address_space(3))) float*)((__attribute__((address_space(3))) const char*)shm+LDS_F)+4*hi;
  const unsigned lds0=(unsigned)(uintptr_t)shm;
  float*wsf=(float*)(shm+LDS_WS)+wid*64;
  const bf16*ksrc=Kh+(long)lane*DMK+wid*8;
  const bf16*vsrc=Vh+(long)(16*(wid&3)+(lane>>2))*DMK+(wid>>2)*32+(lane&3)*8;
  const unsigned kdst=lds0+LDS_K+wid*1024, vdst=lds0+LDS_V+wid*1024;
  #define DMA_K(t,slot) glds16(ksrc+(long)(t)*KVBLK*DMK,(unsigned)__builtin_amdgcn_readfirstlane(kdst+(slot)))
  #define DMA_V(t,slot) glds16(vsrc+(long)(t)*KVBLK*DMK,(unsigned)__builtin_amdgcn_readfirstlane(vdst+(slot)))
  const int vb0=(int)(lds0+LDS_V)+((lane>>4)&1)*32+(lane&3)*8+(4*hi+((lane&15)>>2))*64;
  const char*Kbase=shm+LDS_K; bf16x8 kf[8];
  const lds_cptr shm3=(lds_cptr)shm; const lds_cptr kp0=shm3+LDS_K+hi*1024+r32*16; const lds_cptr vp0=shm3+LDS_V+((lane>>4)&1)*32+(lane&3)*8+(4*hi+((lane&15)>>2))*64;
  const int NT=(q0+QB)/KVBLK;
  DMA_K(0,0);DMA_V(0,0);DMA_K(1,SLOTB);
  bf16x8 qr[4];
  #pragma unroll
  for(int d0=0;d0<4;++d0)qr[d0]=*reinterpret_cast<const bf16x8*>(&Qw[(long)r32*DMQ+d0*16+hi*8]);
  float mhat=0.f,l_reg=0.f;f32x16 o[2];o[0]=f32x16{};o[1]=f32x16{};const f32x16 zero16=f32x16{};
  const int qrel=wid*QBLK+r32;
  #define CMASK(P0,P1,t) do{int jb_=(t)-(NT-4); if(jb_>=0)cmask(P0,P1,jb_,qrel,hi);}while(0)
  #define FBIAS(P0,P1,t) do{ const __attribute__((address_space(3))) float* fb_=fbL+64*(t); \
    _Pragma("unroll") for(int a_=0;a_<4;++a_){ const f32x4 v_=*(const __attribute__((address_space(3))) f32x4*)(fb_+8*a_)-mhat, w_=*(const __attribute__((address_space(3))) f32x4*)(fb_+32+8*a_)-mhat; \
      _Pragma("unroll") for(int i_=0;i_<4;++i_){ P0[4*a_+i_]+=v_[i_]; P1[4*a_+i_]+=w_[i_]; } } }while(0)
  bool resc=false;
  #define START(P0,P1) do{ const float rm=rowmax(P0,P1); resc=false; \
    { const float dl=rm; mhat=fadd_s(mhat,dl); \
      _Pragma("unroll") for(int r=0;r<16;++r){P0[r]=fsub_s(P0[r],dl);P1[r]=fsub_s(P1[r],dl);} \
      } \
    _Pragma("unroll") for(int r=0;r<16;++r)P0[r]=__builtin_amdgcn_exp2f(P0[r]); }while(0)
  #define RESC() do{ if(resc){ asm volatile("s_waitcnt lgkmcnt(0)":::"memory"); \
      _Pragma("unroll") for(int d_=0;d_<2;++d_) _Pragma("unroll") for(int r=0;r<16;++r)o[d_][r]*=wsf[crow(r,hi)]; } }while(0)
  f32x16 pA0,pA1,pB0,pB1;
  int sl_prev=0,sl_cur=0,sl_next=SLOTB;
  #define ROT() do{sl_prev=sl_cur;sl_cur=sl_next;sl_next=(sl_next==(NSLOT-1)*SLOTB)?0:sl_next+SLOTB;}while(0)
  DMA_K(2,2*SLOTB);
  WAIT_BAR(3);
  qkt(pA0,pA1,Kbase,qr,zero16,r32,hi);asm volatile("s_nop 15\n\ts_nop 7":"+v"(pA0),"+v"(pA1));FBIAS(pA0,pA1,0);CMASK(pA0,pA1,0);
  START(pA0,pA1);
  _Pragma("unroll") for(int r=0;r<16;++r)pA1[r]=__builtin_amdgcn_exp2f(pA1[r]);
  WAIT_BAR(0);
  DMA_K(3,0);DMA_V(1,SLOTB);
  ROT();
  kload8(kf,kp0+sl_cur);
  WAIT_BAR(2);
  s16x4 vlo[8],vhi[8]; u32x4 pw0,pw1,pw2,pw3;
  #define PKW(P,B) cvtpk_s(P[B],P[B+1])
  #define PAF(k) __builtin_bit_cast(bf16x8,pw##k)
  #define VFR(i) (bf16x8){vlo[i][0],vlo[i][1],vlo[i][2],vlo[i][3],vhi[i][0],vhi[i][1],vhi[i][2],vhi[i][3]}
  #define PIN(x) asm volatile("":"+v"(x))
  #define MX3(a,b,c) __builtin_fmaxf(__builtin_fmaxf((a),(b)),(c))
  #define GAPA(MF,A0,A1,A2,A3,W0,W1,PW) do{ MF; sacc+=A0; sacc+=A1; sacc+=A2; sacc+=A3; PIN(sacc); W0; W1; PIN(PW); SBAR(); }while(0)
  #define EX(v) __builtin_amdgcn_exp2f(v)
  #define GAPB(MF,X,B) do{ MF; X[B]=EX(X[B]); X[B+1]=EX(X[B+1]); X[B+2]=EX(X[B+2]); X[B+3]=EX(X[B+3]); PIN(X); SBAR(); }while(0)
  #define VRD(i) do{ vlo[i]=vtr(vp_+(((i)>>2)*4096+((i)&3)*1024)); vhi[i]=vtr(vp_+(((i)>>2)*4096+((i)&3)*1024+512)); }while(0)
  #define KRD(G,j) do{ if(G){ kload2(kf,kp0+sl_next,j); SBAR(); } }while(0)
  #define STEP(C0,C1,P0,P1,t,GK,GV,GL) do{ SBAR(); \
    const lds_cptr vp_=vp0+sl_prev; \
    VRD(0); SBAR(); float sacc=(P0[0]+P0[1]); \
    GAPA(C0=__builtin_amdgcn_mfma_f32_32x32x16_bf16(kf[0],qr[0],zero16,0,0,0), P0[2],P0[3],P0[4],P0[5],     pw0[0]=PKW(P0,0), pw0[1]=PKW(P0,2), pw0); \
    VRD(4); SBAR(); GAPA(C1=__builtin_amdgcn_mfma_f32_32x32x16_bf16(kf[1],qr[0],zero16,0,0,0), P0[6],P0[7],P0[8],P0[9],     pw0[2]=PKW(P0,4), pw0[3]=PKW(P0,6), pw0); \
    VRD(1); SBAR(); GAPA(C0=__builtin_amdgcn_mfma_f32_32x32x16_bf16(kf[2],qr[1],C0,0,0,0),   P0[10],P0[11],P0[12],P0[13], pw1[0]=PKW(P0,8), pw1[1]=PKW(P0,10), pw1); \
    VRD(5); SBAR(); GAPA(C1=__builtin_amdgcn_mfma_f32_32x32x16_bf16(kf[3],qr[1],C1,0,0,0),   P0[14],P0[15],P1[0],P1[1],   pw1[2]=PKW(P0,12),pw1[3]=PKW(P0,14), pw1); \
    VRD(2); SBAR(); GAPA(C0=__builtin_amdgcn_mfma_f32_32x32x16_bf16(kf[4],qr[2],C0,0,0,0),   P1[2],P1[3],P1[4],P1[5],     pw2[0]=PKW(P1,0), pw2[1]=PKW(P1,2), pw2); \
    VRD(6); SBAR(); GAPA(C1=__builtin_amdgcn_mfma_f32_32x32x16_bf16(kf[5],qr[2],C1,0,0,0),   P1[6],P1[7],P1[8],P1[9],     pw2[2]=PKW(P1,4), pw2[3]=PKW(P1,6), pw2); \
    VRD(3); SBAR(); GAPA(C0=__builtin_amdgcn_mfma_f32_32x32x16_bf16(kf[6],qr[3],C0,0,0,0),   P1[10],P1[11],P1[12],P1[13], pw3[0]=PKW(P1,8), pw3[1]=PKW(P1,10), pw3); \
    VRD(7); SBAR(); GAPA(C1=__builtin_amdgcn_mfma_f32_32x32x16_bf16(kf[7],qr[3],C1,0,0,0),   P1[14],P1[15],0.f,0.f,       pw3[2]=PKW(P1,12),pw3[3]=PKW(P1,14), pw3); \
    l_reg+=sacc; \
    if(GK){DMA_K((t)+3,sl_cur);} if(GV){DMA_V((t)+1,sl_next);} \
    FBIAS(C0,C1,t); CMASK(C0,C1,t); \
    { float a=MX3(C0[0],C0[1],C1[0]),b=MX3(C0[2],C0[3],C1[1]); a=MX3(a,C1[2],C1[3]); \
      _Pragma("unroll") for(int r=4;r<16;r+=4){a=MX3(a,C0[r],C0[r+1]);b=MX3(b,C0[r+2],C0[r+3]);a=MX3(a,C1[r],C1[r+1]);b=MX3(b,C1[r+2],C1[r+3]);} \
      float rm=__builtin_fmaxf(a,b); { auto rr=__builtin_amdgcn_permlane32_swap(__float_as_uint(rm),__float_as_uint(rm),false,false); rm=__builtin_fmaxf(__uint_as_float(rr[0]),__uint_as_float(rr[1])); } \
      resc=false; \
      if(__builtin_expect(__any(rm>(float)THRL),0)){ const float dl=__builtin_fmaxf(rm,0.f); mhat+=dl; \
        _Pragma("unroll") for(int r=0;r<16;++r){C0[r]-=dl;C1[r]-=dl;} \
        const float f=__builtin_amdgcn_exp2f(-dl); l_reg*=f; if(hi==0)wsf[r32]=f; resc=true; } } \
    SBAR(); \
    GAPB(o[0]=__builtin_amdgcn_mfma_f32_32x32x16_bf16(PAF(0),VFR(0),o[0],0,0,0), C0,0); \
    GAPB(o[1]=__builtin_amdgcn_mfma_f32_32x32x16_bf16(PAF(0),VFR(4),o[1],0,0,0), C0,4); \
    KRD(GL,0); GAPB(o[0]=__builtin_amdgcn_mfma_f32_32x32x16_bf16(PAF(1),VFR(1),o[0],0,0,0), C0,8); \
    KRD(GL,1); GAPB(o[1]=__builtin_amdgcn_mfma_f32_32x32x16_bf16(PAF(1),VFR(5),o[1],0,0,0), C0,12); \
    KRD(GL,2); GAPB(o[0]=__builtin_amdgcn_mfma_f32_32x32x16_bf16(PAF(2),VFR(2),o[0],0,0,0), C1,0); \
    KRD(GL,3); GAPB(o[1]=__builtin_amdgcn_mfma_f32_32x32x16_bf16(PAF(2),VFR(6),o[1],0,0,0), C1,4); \
    GAPB(o[0]=__builtin_amdgcn_mfma_f32_32x32x16_bf16(PAF(3),VFR(3),o[0],0,0,0), C1,8); \
    GAPB(o[1]=__builtin_amdgcn_mfma_f32_32x32x16_bf16(PAF(3),VFR(7),o[1],0,0,0), C1,12); \
    }while(0)
  int t=1;
  #undef CMASK
  #define CMASK(P0,P1,t) do{}while(0)
  for(;t+5<NT;t+=2){
    STEP(pB0,pB1,pA0,pA1,t,true,true,true);     WAIT_BAR(2); RESC(); ROT();
    STEP(pA0,pA1,pB0,pB1,t+1,true,true,true);   WAIT_BAR(2); RESC(); ROT();
  }
  #undef CMASK
  #define CMASK(P0,P1,t) do{int jb_=(t)-(NT-4); if(jb_>=0)cmask(P0,P1,jb_,qrel,hi);}while(0)
  #define ENDW(tt) do{ if((tt)+3<NT){WAIT_BAR(2);} else if((tt)+2<NT){WAIT_BAR(1);} else {WAIT_BAR(0);} }while(0)
  for(;t+1<NT;t+=2){
    STEP(pB0,pB1,pA0,pA1,t,(t+3<NT),(t+1<NT),(t+1<NT));       ENDW(t);   RESC(); ROT();
    STEP(pA0,pA1,pB0,pB1,t+1,(t+4<NT),(t+2<NT),(t+2<NT));     ENDW(t+1); RESC(); ROT();
  }
  STEP(pB0,pB1,pA0,pA1,NT-1,false,false,false); RESC();
  { float sacc=pB0[0]+pB0[1]; _Pragma("unroll") for(int r=2;r<16;++r)sacc+=pB0[r]; _Pragma("unroll") for(int r=0;r<16;++r)sacc+=pB1[r]; l_reg+=sacc;
    pw0=(u32x4){PKW(pB0,0),PKW(pB0,2),PKW(pB0,4),PKW(pB0,6)};pw1=(u32x4){PKW(pB0,8),PKW(pB0,10),PKW(pB0,12),PKW(pB0,14)};pw2=(u32x4){PKW(pB1,0),PKW(pB1,2),PKW(pB1,4),PKW(pB1,6)};pw3=(u32x4){PKW(pB1,8),PKW(pB1,10),PKW(pB1,12),PKW(pB1,14)};
    SBAR(); pv(o,vb0+sl_cur,PAF(0),PAF(1),PAF(2),PAF(3)); }
  #undef PKW
  #undef PAF
  #undef VFR
  #undef PIN
  #undef MX3
  #undef GAPA
  #undef GAPB
  #undef EX
  #undef VRD
  #undef KRD
  #undef STEP
  #undef ENDW
  {auto rr=__builtin_amdgcn_permlane32_swap(__float_as_uint(l_reg),__float_as_uint(l_reg),false,false);l_reg=__uint_as_float(rr[0])+__uint_as_float(rr[1]);}
  if(hi==0)wsf[32+r32]=l_reg;asm volatile("s_waitcnt lgkmcnt(0)":::"memory");
  float rli[16];
  #pragma unroll
  for(int r=0;r<16;++r)rli[r]=__builtin_amdgcn_rcpf(wsf[32+crow(r,hi)]);
  bf16*Ow=Ou+(long)(wid*QBLK)*DMO;
  { bf16*stg=(bf16*)(shm+LDS_OST)+wid*2048;
    #pragma unroll
    for(int r=0;r<16;++r){const int orow=crow(r,hi);
      #pragma unroll
      for(int d0=0;d0<2;++d0)stg[orow*64+d0*32+r32]=(bf16)(cvtpk_s(o[d0][r]*rli[r],0.f)&0xffffu);}
    asm volatile("s_waitcnt lgkmcnt(0)":::"memory");
    #pragma unroll
    for(int i=0;i<4;++i){const int row=i*8+(lane>>3),ch=lane&7; const u32x4 v=*(const u32x4*)(stg+row*64+ch*8); ATTN_STORE16(Ow+(long)row*DMO+ch*8,v);} }
  asm volatile("s_waitcnt lgkmcnt(0)\n\ts_barrier":::"memory");
  #undef DMA_K
  #undef DMA_V
  #undef CMASK
  #undef FBIAS
  #undef START
  #undef RESC
  #undef ROT
}
#undef SBAR
#undef WAIT_BAR
}
namespace fx {
using u32x4=__attribute__((ext_vector_type(4)))unsigned;
constexpr int NW=8,QBLK=32,QB=QBLK*NW,KVBLK=64;
__device__ __forceinline__ int crow(int r,int hi){return (r&3)+8*(r>>2)+4*hi;}
#define SBAR() __builtin_amdgcn_sched_barrier(0)
__device__ __forceinline__ void cmask(f32x16&p0,f32x16&p1,int jb,int qrel,int hi){
  const float NEG=-INFINITY; int kb=64*jb+4*hi;
  #pragma unroll
  for(int r=0;r<16;++r){int kv=kb+(r&3)+8*(r>>2); if(kv>qrel)p0[r]=NEG; if(kv+32>qrel)p1[r]=NEG;}
}

constexpr int NSLOT=3, SLOTB=8192;
constexpr int LDS_K=0, LDS_V=NSLOT*SLOTB, LDS_WS=2*NSLOT*SLOTB, LDS_OST=LDS_WS+NW*64*4, LDS_BYTES=LDS_OST+NW*4096, LDS_F=LDS_BYTES  , LDS_END=LDS_F+16384;
__device__ __forceinline__ void glds16(const void*gsrc,unsigned lds_dst){unsigned keep;
  asm volatile("s_mov_b32 %0, m0\n\ts_mov_b32 m0, %2\n\ts_nop 0\n\tglobal_load_lds_dwordx4 %1, off\n\ts_mov_b32 m0, %0":"=&s"(keep):"v"(gsrc),"s"(lds_dst):"memory");}
__device__ __forceinline__ float max3f(float a,float b,float c){float r;asm("v_max3_f32 %0, %1, %2, %3":"=v"(r):"v"(a),"v"(b),"v"(c));return r;}
__device__ __forceinline__ float max2f(float a,float b){float r;asm("v_max_f32_e32 %0, %1, %2":"=v"(r):"v"(a),"v"(b));return r;}
__device__ __forceinline__ float fadd_s(float a,float b){float r;asm("v_add_f32_e32 %0, %1, %2":"=v"(r):"v"(a),"v"(b));return r;}
__device__ __forceinline__ float fsub_s(float a,float b){float r;asm("v_sub_f32_e32 %0, %1, %2":"=v"(r):"v"(a),"v"(b));return r;}
typedef float f32x2_t __attribute__((ext_vector_type(2))); typedef __bf16 bf16x2_t __attribute__((ext_vector_type(2)));
__device__ __forceinline__ unsigned cvtpk_s(float lo,float hi){f32x2_t v={lo,hi};bf16x2_t b=__builtin_convertvector(v,bf16x2_t);return __builtin_bit_cast(unsigned,b);}
#define WAIT_BAR(N) asm volatile("s_waitcnt vmcnt(" #N ") lgkmcnt(0)\n\ts_barrier":::"memory")

__device__ __forceinline__ void qkt(f32x16&p0,f32x16&p1,const char*Kslot,const bf16x8*qr,const f32x16&negm,int r32,int hi){
  const char*kb=Kslot+hi*1024+r32*16;
  #pragma unroll
  for(int d0=0;d0<4;++d0){
    const bf16x8 b0=*reinterpret_cast<const bf16x8*>(kb+d0*2048);
    const bf16x8 b1=*reinterpret_cast<const bf16x8*>(kb+d0*2048+512);
    if(d0==0){p0=__builtin_amdgcn_mfma_f32_32x32x16_bf16(b0,qr[0],negm,0,0,0);p1=__builtin_amdgcn_mfma_f32_32x32x16_bf16(b1,qr[0],negm,0,0,0);}
    else{p0=__builtin_amdgcn_mfma_f32_32x32x16_bf16(b0,qr[d0],p0,0,0,0);p1=__builtin_amdgcn_mfma_f32_32x32x16_bf16(b1,qr[d0],p1,0,0,0);}}
}
typedef __attribute__((address_space(3))) const char* lds_cptr;
typedef short v4i16_t __attribute__((ext_vector_type(4)));
__device__ __forceinline__ void kload8(bf16x8*kf,lds_cptr kp){
  kf[0]=*(const __attribute__((address_space(3))) bf16x8*)(kp);      kf[1]=*(const __attribute__((address_space(3))) bf16x8*)(kp+512);
  kf[2]=*(const __attribute__((address_space(3))) bf16x8*)(kp+2048); kf[3]=*(const __attribute__((address_space(3))) bf16x8*)(kp+2560);
  kf[4]=*(const __attribute__((address_space(3))) bf16x8*)(kp+4096); kf[5]=*(const __attribute__((address_space(3))) bf16x8*)(kp+4608);
  kf[6]=*(const __attribute__((address_space(3))) bf16x8*)(kp+6144); kf[7]=*(const __attribute__((address_space(3))) bf16x8*)(kp+6656);
}
__device__ __forceinline__ void kload2(bf16x8*kf,lds_cptr kp,int j){ kf[2*j]=*(const __attribute__((address_space(3))) bf16x8*)(kp+j*2048); kf[2*j+1]=*(const __attribute__((address_space(3))) bf16x8*)(kp+j*2048+512); }
__device__ __forceinline__ s16x4 vtr(lds_cptr p){ return __builtin_bit_cast(s16x4,__builtin_amdgcn_ds_read_tr16_b64_v4i16((__attribute__((address_space(3))) v4i16_t*)p)); }
__device__ __forceinline__ float rowmax(const f32x16&p0,const f32x16&p1){
  float a=max3f(p0[0],p0[1],p1[0]),b=max3f(p0[2],p0[3],p1[1]);a=max3f(a,p1[2],p1[3]);
  #pragma unroll
  for(int r=4;r<16;r+=4){a=max3f(a,p0[r],p0[r+1]);b=max3f(b,p0[r+2],p0[r+3]);a=max3f(a,p1[r],p1[r+1]);b=max3f(b,p1[r+2],p1[r+3]);}
  const float m=max2f(a,b);
  auto rr=__builtin_amdgcn_permlane32_swap(__float_as_uint(m),__float_as_uint(m),false,false);
  return max2f(__uint_as_float(rr[0]),__uint_as_float(rr[1]));
}
__device__ __forceinline__ void pv(f32x16*o,int vb,bf16x8 pa0,bf16x8 pa1,bf16x8 pa2,bf16x8 pa3){
  #pragma unroll
  for(int d0=0;d0<2;++d0){s16x4 lo[4],hi[4];
    #pragma unroll
    for(int ks=0;ks<4;++ks){
      asm volatile("ds_read_b64_tr_b16 %0,%1 offset:%c2":"=&v"(lo[ks]):"v"(vb),"i"(d0*4096+ks*1024):"memory");
      asm volatile("ds_read_b64_tr_b16 %0,%1 offset:%c2":"=&v"(hi[ks]):"v"(vb),"i"(d0*4096+ks*1024+512):"memory");}
    asm volatile("s_waitcnt lgkmcnt(0)":::"memory");SBAR();
    #define PK(k) (bf16x8){lo[k][0],lo[k][1],lo[k][2],lo[k][3],hi[k][0],hi[k][1],hi[k][2],hi[k][3]}
    o[d0]=__builtin_amdgcn_mfma_f32_32x32x16_bf16(pa0,PK(0),o[d0],0,0,0);
    o[d0]=__builtin_amdgcn_mfma_f32_32x32x16_bf16(pa1,PK(1),o[d0],0,0,0);
    o[d0]=__builtin_amdgcn_mfma_f32_32x32x16_bf16(pa2,PK(2),o[d0],0,0,0);
    o[d0]=__builtin_amdgcn_mfma_f32_32x32x16_bf16(pa3,PK(3),o[d0],0,0,0);
    #undef PK
  }
}

#ifndef ATTN_STORE16
#define ATTN_STORE16(p,v) (*(u32x4*)(p)=(v))
#endif
enum { MODE_FOX = 0, MODE_SEL = 1 };
struct HookP { const __attribute__((address_space(3))) float* tab; int qrel, ti, tq; unsigned long long sel; float b31; };
__device__ __forceinline__ void sel_near(f32x16&p0,f32x16&p1,const __attribute__((address_space(3))) float* lut,int d0,float ca){
  #pragma unroll
  for(int r=0;r<16;++r){ const int kk=(r&3)+8*(r>>2); const int di=d0-kk, dj=di-32;
    p0[r]+=lut[di<0?0:(di>127?127:di)]+ca; p1[r]+=lut[dj<0?0:(dj>127?127:dj)]+ca;
    if(di<0)p0[r]=-INFINITY; if(dj<0)p1[r]=-INFINITY; }
}
template<int THRL,int MODE,int DMK> __device__ __forceinline__ void attn_core(int tid_,int NT,const bf16*qrow,const bf16*__restrict__ Kh,const bf16*__restrict__ Vh,char*shm,const HookP hp,f32x16 (&o)[2],float&l_out){
  const int tid=tid_,lane=tid&63,r32=lane&31,hi=lane>>5; const int wid=__builtin_amdgcn_readfirstlane(tid>>6);
  const unsigned lds0=(unsigned)(uintptr_t)shm;
  float*wsf=(float*)(shm+LDS_WS)+wid*64;
  const bf16*ksrc=Kh+(long)lane*DMK+wid*8;
  const bf16*vsrc=Vh+(long)(16*(wid&3)+(lane>>2))*DMK+(wid>>2)*32+(lane&3)*8;
  const unsigned kdst=lds0+LDS_K+wid*1024, vdst=lds0+LDS_V+wid*1024;
  #define DMA_K(t,slot) glds16(ksrc+(long)(t)*KVBLK*DMK,(unsigned)__builtin_amdgcn_readfirstlane(kdst+(slot)))
  #define DMA_V(t,slot) glds16(vsrc+(long)(t)*KVBLK*DMK,(unsigned)__builtin_amdgcn_readfirstlane(vdst+(slot)))
  const int vb0=(int)(lds0+LDS_V)+((lane>>4)&1)*32+(lane&3)*8+(4*hi+((lane&15)>>2))*64;
  const char*Kbase=shm+LDS_K; bf16x8 kf[8];
  const lds_cptr shm3=(lds_cptr)shm; const lds_cptr kp0=shm3+LDS_K+hi*1024+r32*16; const lds_cptr vp0=shm3+LDS_V+((lane>>4)&1)*32+(lane&3)*8+(4*hi+((lane&15)>>2))*64;
  DMA_K(0,0);DMA_V(0,0);DMA_K(1,SLOTB);
  bf16x8 qr[4];
  #pragma unroll
  for(int d0=0;d0<4;++d0)qr[d0]=*reinterpret_cast<const bf16x8*>(&qrow[d0*16+hi*8]);
  float mhat=0.f,l_reg=0.f;o[0]=f32x16{};o[1]=f32x16{};const f32x16 zero16=f32x16{};
  #define FBIAS(P0,P1,t) do{ const __attribute__((address_space(3))) float* fb_=hp.tab+64*(t); \
    _Pragma("unroll") for(int a_=0;a_<4;++a_){ const f32x4 v_=*(const __attribute__((address_space(3))) f32x4*)(fb_+8*a_)-mhat, w_=*(const __attribute__((address_space(3))) f32x4*)(fb_+32+8*a_)-mhat; \
      _Pragma("unroll") for(int i_=0;i_<4;++i_){ P0[4*a_+i_]+=v_[i_]; P1[4*a_+i_]+=w_[i_]; } } }while(0)
  #define HOOK(P0,P1,t,BAND) do{ \
    if(MODE==MODE_FOX){ FBIAS(P0,P1,t); if(BAND){ const int jb_=(t)-(NT-4); if(jb_>=0)cmask(P0,P1,jb_,hp.qrel,hi); } } \
    else { const bool on_=((hp.sel>>(t))&1ull)!=0ull; \
      if(!(BAND)||(t)+3<=hp.ti){ const float ca_=on_?(hp.b31-mhat):-INFINITY; _Pragma("unroll") for(int r_=0;r_<16;++r_){P0[r_]+=ca_;P1[r_]+=ca_;} } \
      else sel_near(P0,P1,hp.tab,hp.tq-64*(t)-4*hi,on_?-mhat:-INFINITY); } }while(0)
  bool resc=false;
  #define START(P0,P1) do{ const float rm=rowmax(P0,P1); resc=false; \
    { const float dl=rm; mhat=fadd_s(mhat,dl); \
      _Pragma("unroll") for(int r=0;r<16;++r){P0[r]=fsub_s(P0[r],dl);P1[r]=fsub_s(P1[r],dl);} \
      } \
    _Pragma("unroll") for(int r=0;r<16;++r)P0[r]=__builtin_amdgcn_exp2f(P0[r]); }while(0)
  #define RESC() do{ if(resc){ asm volatile("s_waitcnt lgkmcnt(0)":::"memory"); \
      _Pragma("unroll") for(int d_=0;d_<2;++d_) _Pragma("unroll") for(int r=0;r<16;++r)o[d_][r]*=wsf[crow(r,hi)]; } }while(0)
  f32x16 pA0,pA1,pB0,pB1;
  int sl_prev=0,sl_cur=0,sl_next=SLOTB;
  #define ROT() do{sl_prev=sl_cur;sl_cur=sl_next;sl_next=(sl_next==(NSLOT-1)*SLOTB)?0:sl_next+SLOTB;}while(0)
  DMA_K(2,2*SLOTB);
  WAIT_BAR(3);
  qkt(pA0,pA1,Kbase,qr,zero16,r32,hi);asm volatile("s_nop 15\n\ts_nop 7":"+v"(pA0),"+v"(pA1));HOOK(pA0,pA1,0,1);
  START(pA0,pA1);
  _Pragma("unroll") for(int r=0;r<16;++r)pA1[r]=__builtin_amdgcn_exp2f(pA1[r]);
  WAIT_BAR(0);
  DMA_K(3,0);DMA_V(1,SLOTB);
  ROT();
  kload8(kf,kp0+sl_cur);
  WAIT_BAR(2);
  s16x4 vlo[8],vhi[8]; u32x4 pw0,pw1,pw2,pw3;
  #define PKW(P,B) cvtpk_s(P[B],P[B+1])
  #define PAF(k) __builtin_bit_cast(bf16x8,pw##k)
  #define VFR(i) (bf16x8){vlo[i][0],vlo[i][1],vlo[i][2],vlo[i][3],vhi[i][0],vhi[i][1],vhi[i][2],vhi[i][3]}
  #define PIN(x) asm volatile("":"+v"(x))
  #define MX3(a,b,c) __builtin_fmaxf(__builtin_fmaxf((a),(b)),(c))
  #define GAPA(MF,A0,A1,A2,A3,W0,W1,PW) do{ MF; sacc+=A0; sacc+=A1; sacc+=A2; sacc+=A3; PIN(sacc); W0; W1; PIN(PW); SBAR(); }while(0)
  #define EX(v) __builtin_amdgcn_exp2f(v)
  #define GAPB(MF,X,B) do{ MF; X[B]=EX(X[B]); X[B+1]=EX(X[B+1]); X[B+2]=EX(X[B+2]); X[B+3]=EX(X[B+3]); PIN(X); SBAR(); }while(0)
  #define VRD(i) do{ vlo[i]=vtr(vp_+(((i)>>2)*4096+((i)&3)*1024)); vhi[i]=vtr(vp_+(((i)>>2)*4096+((i)&3)*1024+512)); }while(0)
  #define KRD(G,j) do{ if(G){ kload2(kf,kp0+sl_next,j); SBAR(); } }while(0)
  #define STEP(C0,C1,P0,P1,t,GK,GV,GL,BAND) do{ SBAR(); \
    const lds_cptr vp_=vp0+sl_prev; \
    VRD(0); SBAR(); float sacc=(P0[0]+P0[1]); \
    GAPA(C0=__builtin_amdgcn_mfma_f32_32x32x16_bf16(kf[0],qr[0],zero16,0,0,0), P0[2],P0[3],P0[4],P0[5],     pw0[0]=PKW(P0,0), pw0[1]=PKW(P0,2), pw0); \
    VRD(4); SBAR(); GAPA(C1=__builtin_amdgcn_mfma_f32_32x32x16_bf16(kf[1],qr[0],zero16,0,0,0), P0[6],P0[7],P0[8],P0[9],     pw0[2]=PKW(P0,4), pw0[3]=PKW(P0,6), pw0); \
    VRD(1); SBAR(); GAPA(C0=__builtin_amdgcn_mfma_f32_32x32x16_bf16(kf[2],qr[1],C0,0,0,0),   P0[10],P0[11],P0[12],P0[13], pw1[0]=PKW(P0,8), pw1[1]=PKW(P0,10), pw1); \
    VRD(5); SBAR(); GAPA(C1=__builtin_amdgcn_mfma_f32_32x32x16_bf16(kf[3],qr[1],C1,0,0,0),   P0[14],P0[15],P1[0],P1[1],   pw1[2]=PKW(P0,12),pw1[3]=PKW(P0,14), pw1); \
    VRD(2); SBAR(); GAPA(C0=__builtin_amdgcn_mfma_f32_32x32x16_bf16(kf[4],qr[2],C0,0,0,0),   P1[2],P1[3],P1[4],P1[5],     pw2[0]=PKW(P1,0), pw2[1]=PKW(P1,2), pw2); \
    VRD(6); SBAR(); GAPA(C1=__builtin_amdgcn_mfma_f32_32x32x16_bf16(kf[5],qr[2],C1,0,0,0),   P1[6],P1[7],P1[8],P1[9],     pw2[2]=PKW(P1,4), pw2[3]=PKW(P1,6), pw2); \
    VRD(3); SBAR(); GAPA(C0=__builtin_amdgcn_mfma_f32_32x32x16_bf16(kf[6],qr[3],C0,0,0,0),   P1[10],P1[11],P1[12],P1[13], pw3[0]=PKW(P1,8), pw3[1]=PKW(P1,10), pw3); \
    VRD(7); SBAR(); GAPA(C1=__builtin_amdgcn_mfma_f32_32x32x16_bf16(kf[7],qr[3],C1,0,0,0),   P1[14],P1[15],0.f,0.f,       pw3[2]=PKW(P1,12),pw3[3]=PKW(P1,14), pw3); \
    l_reg+=sacc; \
    if(GK){DMA_K((t)+3,sl_cur);} if(GV){DMA_V((t)+1,sl_next);} \
    HOOK(C0,C1,t,BAND); \
    { float a=MX3(C0[0],C0[1],C1[0]),b=MX3(C0[2],C0[3],C1[1]); a=MX3(a,C1[2],C1[3]); \
      _Pragma("unroll") for(int r=4;r<16;r+=4){a=MX3(a,C0[r],C0[r+1]);b=MX3(b,C0[r+2],C0[r+3]);a=MX3(a,C1[r],C1[r+1]);b=MX3(b,C1[r+2],C1[r+3]);} \
      float rm=__builtin_fmaxf(a,b); { auto rr=__builtin_amdgcn_permlane32_swap(__float_as_uint(rm),__float_as_uint(rm),false,false); rm=__builtin_fmaxf(__uint_as_float(rr[0]),__uint_as_float(rr[1])); } \
      resc=false; \
      if(__builtin_expect(__any(rm>(float)THRL),0)){ const float dl=__builtin_fmaxf(rm,0.f); mhat+=dl; \
        _Pragma("unroll") for(int r=0;r<16;++r){C0[r]-=dl;C1[r]-=dl;} \
        const float f=__builtin_amdgcn_exp2f(-dl); l_reg*=f; if(hi==0)wsf[r32]=f; resc=true; } } \
    SBAR(); \
    GAPB(o[0]=__builtin_amdgcn_mfma_f32_32x32x16_bf16(PAF(0),VFR(0),o[0],0,0,0), C0,0); \
    GAPB(o[1]=__builtin_amdgcn_mfma_f32_32x32x16_bf16(PAF(0),VFR(4),o[1],0,0,0), C0,4); \
    KRD(GL,0); GAPB(o[0]=__builtin_amdgcn_mfma_f32_32x32x16_bf16(PAF(1),VFR(1),o[0],0,0,0), C0,8); \
    KRD(GL,1); GAPB(o[1]=__builtin_amdgcn_mfma_f32_32x32x16_bf16(PAF(1),VFR(5),o[1],0,0,0), C0,12); \
    KRD(GL,2); GAPB(o[0]=__builtin_amdgcn_mfma_f32_32x32x16_bf16(PAF(2),VFR(2),o[0],0,0,0), C1,0); \
    KRD(GL,3); GAPB(o[1]=__builtin_amdgcn_mfma_f32_32x32x16_bf16(PAF(2),VFR(6),o[1],0,0,0), C1,4); \
    GAPB(o[0]=__builtin_amdgcn_mfma_f32_32x32x16_bf16(PAF(3),VFR(3),o[0],0,0,0), C1,8); \
    GAPB(o[1]=__builtin_amdgcn_mfma_f32_32x32x16_bf16(PAF(3),VFR(7),o[1],0,0,0), C1,12); \
    }while(0)
  int t=1;
  for(;t+5<NT;t+=2){
    STEP(pB0,pB1,pA0,pA1,t,true,true,true,0);     WAIT_BAR(2); RESC(); ROT();
    STEP(pA0,pA1,pB0,pB1,t+1,true,true,true,0);   WAIT_BAR(2); RESC(); ROT();
  }
  #define ENDW(tt) do{ if((tt)+3<NT){WAIT_BAR(2);} else if((tt)+2<NT){WAIT_BAR(1);} else {WAIT_BAR(0);} }while(0)
  for(;t+1<NT;t+=2){
    STEP(pB0,pB1,pA0,pA1,t,(t+3<NT),(t+1<NT),(t+1<NT),1);       ENDW(t);   RESC(); ROT();
    STEP(pA0,pA1,pB0,pB1,t+1,(t+4<NT),(t+2<NT),(t+2<NT),1);     ENDW(t+1); RESC(); ROT();
  }
  STEP(pB0,pB1,pA0,pA1,NT-1,false,false,false,1); RESC();
  { float sacc=pB0[0]+pB0[1]; _Pragma("unroll") for(int r=2;r<16;++r)sacc+=pB0[r]; _Pragma("unroll") for(int r=0;r<16;++r)sacc+=pB1[r]; l_reg+=sacc;
    pw0=(u32x4){PKW(pB0,0),PKW(pB0,2),PKW(pB0,4),PKW(pB0,6)};pw1=(u32x4){PKW(pB0,8),PKW(pB0,10),PKW(pB0,12),PKW(pB0,14)};pw2=(u32x4){PKW(pB1,0),PKW(pB1,2),PKW(pB1,4),PKW(pB1,6)};pw3=(u32x4){PKW(pB1,8),PKW(pB1,10),PKW(pB1,12),PKW(pB1,14)};
    SBAR(); pv(o,vb0+sl_cur,PAF(0),PAF(1),PAF(2),PAF(3)); }
  #undef PKW
  #undef PAF
  #undef VFR
  #undef PIN
  #undef MX3
  #undef GAPA
  #undef GAPB
  #undef EX
  #undef VRD
  #undef KRD
  #undef STEP
  #undef ENDW
  {auto rr=__builtin_amdgcn_permlane32_swap(__float_as_uint(l_reg),__float_as_uint(l_reg),false,false);l_out=__uint_as_float(rr[0])+__uint_as_float(rr[1]);}
  asm volatile("s_waitcnt lgkmcnt(0)\n\ts_barrier":::"memory");
  #undef DMA_K
  #undef DMA_V
  #undef HOOK
  #undef FBIAS
  #undef START
  #undef RESC
  #undef ROT
}
template<int THRL,int DMQ,int DMK,int DMO> __device__ __forceinline__ void attn_unit(int tid_,int q0,const bf16*Qu,const bf16*__restrict__ Kh,const bf16*__restrict__ Vh,bf16*Ou,char*shm){
  const int tid=tid_,lane=tid&63,r32=lane&31,hi=lane>>5; const int wid=__builtin_amdgcn_readfirstlane(tid>>6);
  HookP hp; hp.tab=(const __attribute__((address_space(3))) float*)((__attribute__((address_space(3))) const char*)shm+LDS_F)+4*hi; hp.qrel=wid*QBLK+r32; hp.ti=0; hp.tq=0; hp.sel=0ull; hp.b31=0.f;
  f32x16 o[2]; float l_reg;
  attn_core<THRL,MODE_FOX,DMK>(tid_,(q0+QB)/KVBLK,Qu+(long)(wid*QBLK+r32)*DMQ,Kh,Vh,shm,hp,o,l_reg);
  float*wsf=(float*)(shm+LDS_WS)+wid*64;
  if(hi==0)wsf[32+r32]=l_reg;asm volatile("s_waitcnt lgkmcnt(0)":::"memory");
  float rli[16];
  #pragma unroll
  for(int r=0;r<16;++r)rli[r]=__builtin_amdgcn_rcpf(wsf[32+crow(r,hi)]);
  bf16*Ow=Ou+(long)(wid*QBLK)*DMO;
  { bf16*stg=(bf16*)(shm+LDS_OST)+wid*2048;
    #pragma unroll
    for(int r=0;r<16;++r){const int orow=crow(r,hi);
      #pragma unroll
      for(int d0=0;d0<2;++d0)stg[orow*64+d0*32+r32]=(bf16)(cvtpk_s(o[d0][r]*rli[r],0.f)&0xffffu);}
    asm volatile("s_waitcnt lgkmcnt(0)":::"memory");
    #pragma unroll
    for(int i=0;i<4;++i){const int row=i*8+(lane>>3),ch=lane&7; const u32x4 v=*(const u32x4*)(stg+row*64+ch*8); ATTN_STORE16(Ow+(long)row*DMO+ch*8,v);} }
  asm volatile("s_waitcnt lgkmcnt(0)\n\ts_barrier":::"memory");
}
#undef SBAR
#undef WAIT_BAR
}
namespace att {
constexpr int SLOTB = 8192;
constexpr int A_K = 0, A_V = 2 * SLOTB, A_WS = fx::LDS_WS, A_OST = fx::LDS_OST, A_F = fx::LDS_F, A_SEL = A_OST + 65536, A_LUT = A_SEL + 512,
              A_LINV = A_LUT + 6144, A_IMP2 = A_LINV + 1024, A_Q = A_IMP2 + 64 * 65 * 4, A_END = A_Q + 64;
constexpr int A_IMPRAW = A_OST;
static_assert(4 * SLOTB <= A_WS && A_IMPRAW + 65536 == A_SEL && A_END <= RING_BYTES && fx::LDS_END <= A_SEL, "attention LDS map");
enum { MODE_FOX = 0, MODE_SEL = 1, MODE_WIN = 2, MODE_CMPA = 3, MODE_CMPB = 4 };
struct BrP { int tq, ti, lutoff, tdiag; unsigned long long sel; float b31; };
#define ATT_NEG (-INFINITY)
__device__ __forceinline__ int crow(int r, int hi) { return (r & 3) + 8 * (r >> 2) + 4 * hi; }
__device__ __forceinline__ void glds16(const void* gsrc, unsigned lds_dst) { unsigned keep;
    asm volatile("s_mov_b32 %0, m0\n\ts_mov_b32 m0, %2\n\ts_nop 0\n\tglobal_load_lds_dwordx4 %1, off\n\ts_mov_b32 m0, %0" : "=&s"(keep) : "v"(gsrc), "s"(lds_dst) : "memory"); }
#define ATT_WAIT_BAR0() asm volatile("s_waitcnt vmcnt(0) lgkmcnt(0)\n\ts_barrier" ::: "memory")
#define ATT_LBAR() asm volatile("s_waitcnt lgkmcnt(0)\n\ts_barrier" ::: "memory")
__device__ __forceinline__ float xhalf_max(float m) { auto rr = __builtin_amdgcn_permlane32_swap(__float_as_uint(m), __float_as_uint(m), false, false); return fmaxf(__uint_as_float(rr[0]), __uint_as_float(rr[1])); }
__device__ __forceinline__ float xhalf_sum(float m) { auto rr = __builtin_amdgcn_permlane32_swap(__float_as_uint(m), __float_as_uint(m), false, false); return __uint_as_float(rr[0]) + __uint_as_float(rr[1]); }
__device__ __forceinline__ void qkt(f32x16& p0, f32x16& p1, const LAS unsigned char* kb, const bf16x8 (&qr)[4]) {
    const f32x16 z = {};
#pragma unroll
    for (int d0 = 0; d0 < 4; ++d0) {
        const bf16x8 b0 = *(const LAS bf16x8*)(kb + d0 * 2048), b1 = *(const LAS bf16x8*)(kb + d0 * 2048 + 512);
        p0 = __builtin_amdgcn_mfma_f32_32x32x16_bf16(b0, qr[d0], d0 ? p0 : z, 0, 0, 0);
        p1 = __builtin_amdgcn_mfma_f32_32x32x16_bf16(b1, qr[d0], d0 ? p1 : z, 0, 0, 0); }
}
__device__ __forceinline__ void pv(f32x16 (&o)[2], int vb, bf16x8 pa0, bf16x8 pa1, bf16x8 pa2, bf16x8 pa3) {
#pragma unroll
    for (int d0 = 0; d0 < 2; ++d0) { s16x4 lo[4], hi[4];
#pragma unroll
        for (int ks = 0; ks < 4; ++ks) {
            asm volatile("ds_read_b64_tr_b16 %0,%1 offset:%c2" : "=&v"(lo[ks]) : "v"(vb), "i"(d0 * 4096 + ks * 1024) : "memory");
            asm volatile("ds_read_b64_tr_b16 %0,%1 offset:%c2" : "=&v"(hi[ks]) : "v"(vb), "i"(d0 * 4096 + ks * 1024 + 512) : "memory"); }
        asm volatile("s_waitcnt lgkmcnt(0)" ::: "memory"); __builtin_amdgcn_sched_barrier(0);
#define ATT_PK(k) (bf16x8){lo[k][0], lo[k][1], lo[k][2], lo[k][3], hi[k][0], hi[k][1], hi[k][2], hi[k][3]}
        o[d0] = __builtin_amdgcn_mfma_f32_32x32x16_bf16(pa0, ATT_PK(0), o[d0], 0, 0, 0);
        o[d0] = __builtin_amdgcn_mfma_f32_32x32x16_bf16(pa1, ATT_PK(1), o[d0], 0, 0, 0);
        o[d0] = __builtin_amdgcn_mfma_f32_32x32x16_bf16(pa2, ATT_PK(2), o[d0], 0, 0, 0);
        o[d0] = __builtin_amdgcn_mfma_f32_32x32x16_bf16(pa3, ATT_PK(3), o[d0], 0, 0, 0);
#undef ATT_PK
    }
}
__device__ __forceinline__ void o_rowscale(f32x16 (&o)[2], LAS float* wsf, float f, int r32, int hi, bool accumulate, f32x16 (&acc)[2]) {
    if (hi == 0) wsf[r32] = f;
    LDS_WAIT();
#pragma unroll
    for (int a = 0; a < 4; ++a) { const f32x4 s = *(const LAS f32x4*)(wsf + 8 * a + 4 * hi);
#pragma unroll
        for (int i = 0; i < 4; ++i) {
            if (accumulate) { acc[0][4 * a + i] += o[0][4 * a + i] * s[i]; acc[1][4 * a + i] += o[1][4 * a + i] * s[i]; }
            else { o[0][4 * a + i] *= s[i]; o[1][4 * a + i] *= s[i]; } } }
    LDS_WAIT();
}
__device__ __forceinline__ void ot_update(LAS float* otw, f32x16 (&o)[2], LAS float* wsf, float f, int r32, int hi, int mode) {
    if (hi == 0) wsf[r32] = f;
    LDS_WAIT();
#pragma unroll
    for (int a = 0; a < 4; ++a) { const f32x4 s = *(const LAS f32x4*)(wsf + 8 * a + 4 * hi);
#pragma unroll
        for (int i = 0; i < 4; ++i)
#pragma unroll
            for (int d0 = 0; d0 < 2; ++d0) { LAS float* p = otw + (8 * a + 4 * hi + i) * 64 + 32 * d0 + r32; float v = o[d0][4 * a + i] * s[i];
                if (mode) v += *p;
                if (mode < 2) *p = v; else o[d0][4 * a + i] = v; } }
    LDS_WAIT();
}
template <int MODE>
__device__ __forceinline__ void run_branch(LAS unsigned char* lds, const bf16* Kg, const bf16* Vg, int pitch, int tb, int te, const bf16x8 (&qr)[4], f32x16 (&o)[2], float& m, float& l,
                                           const BrP P, int wid, int lane, LAS float* improw, bool want_imp, int tskip) {
    const int r32 = lane & 31, hi = lane >> 5;
    const unsigned lds0 = (unsigned)(uintptr_t)lds;
    const bf16* ksrc = Kg + (size_t)lane * pitch + wid * 8;
    const bf16* vsrc = Vg + (size_t)(16 * (wid & 3) + (lane >> 2)) * pitch + (wid >> 2) * 32 + (lane & 3) * 8;
    const unsigned kdst = lds0 + A_K + wid * 1024, vdst = lds0 + A_V + wid * 1024;
    const LAS unsigned char* kp0 = lds + A_K + hi * 1024 + r32 * 16;
    const int vb0 = (int)(lds0 + A_V) + ((lane >> 4) & 1) * 32 + (lane & 3) * 8 + (4 * hi + ((lane & 15) >> 2)) * 64;
    LAS float* wsf = (LAS float*)(lds + A_WS) + wid * 64;
    const LAS float* lut = (const LAS float*)(lds + A_LUT) + P.lutoff;
    float carry = 0.f;
    if (tb < te) { glds16(ksrc + (size_t)tb * 64 * pitch, (unsigned)__builtin_amdgcn_readfirstlane(kdst));
                   if (MODE != MODE_CMPA) glds16(vsrc + (size_t)tb * 64 * pitch, (unsigned)__builtin_amdgcn_readfirstlane(vdst)); }
    for (int t = tb; t < te; ++t) {
        const int cur = ((t - tb) & 1) * SLOTB;
        ATT_WAIT_BAR0();
        if (t + 1 < te) { glds16(ksrc + (size_t)(t + 1) * 64 * pitch, (unsigned)__builtin_amdgcn_readfirstlane(kdst + (cur ^ SLOTB)));
                          if (MODE != MODE_CMPA) glds16(vsrc + (size_t)(t + 1) * 64 * pitch, (unsigned)__builtin_amdgcn_readfirstlane(vdst + (cur ^ SLOTB))); }
        if (MODE == MODE_FOX && t > tskip) continue;
        f32x16 p0, p1; qkt(p0, p1, kp0 + cur, qr);
        if constexpr (MODE == MODE_FOX) {
            const LAS float* fb = (const LAS float*)(lds + A_F) + 64 * t + 4 * hi;
#pragma unroll
            for (int a = 0; a < 4; ++a) { const f32x4 v = *(const LAS f32x4*)(fb + 8 * a), w = *(const LAS f32x4*)(fb + 32 + 8 * a);
#pragma unroll
                for (int i = 0; i < 4; ++i) { p0[4 * a + i] += v[i]; p1[4 * a + i] += w[i]; } }
            if (t >= P.tdiag) { const int d0 = P.tq - 64 * t - 4 * hi;
#pragma unroll
                for (int r = 0; r < 16; ++r) { const int kk = (r & 3) + 8 * (r >> 2); if (kk > d0) p0[r] = ATT_NEG; if (kk + 32 > d0) p1[r] = ATT_NEG; } }
        }
        if constexpr (MODE == MODE_SEL || MODE == MODE_WIN) {
            const int d0 = P.tq - 64 * t - 4 * hi;
            if (t + 3 <= P.ti) {
#pragma unroll
                for (int r = 0; r < 16; ++r) { p0[r] += P.b31; p1[r] += P.b31; }
                if (MODE == MODE_WIN && t + 8 == P.ti) {
#pragma unroll
                    for (int r = 0; r < 16; ++r) { const int kk = (r & 3) + 8 * (r >> 2); if (d0 - kk > 511) p0[r] = ATT_NEG; if (d0 - kk - 32 > 511) p1[r] = ATT_NEG; } }
            } else {
#pragma unroll
                for (int r = 0; r < 16; ++r) { const int kk = (r & 3) + 8 * (r >> 2); const int di = d0 - kk, dj = di - 32;
                    p0[r] += lut[di < 0 ? 0 : (di > 127 ? 127 : di)]; p1[r] += lut[dj < 0 ? 0 : (dj > 127 ? 127 : dj)];
                    if (di < 0) p0[r] = ATT_NEG; if (dj < 0) p1[r] = ATT_NEG; } }
            if (MODE == MODE_SEL) { if (!((P.sel >> t) & 1ull)) {
#pragma unroll
                for (int r = 0; r < 16; ++r) { p0[r] = ATT_NEG; p1[r] = ATT_NEG; } } }
        }
        if constexpr (MODE == MODE_CMPA || MODE == MODE_CMPB) {
            const int e0 = P.tq - 31 - 1024 * t - 64 * hi;
#pragma unroll
            for (int r = 0; r < 16; ++r) { const int kk = (r & 3) + 8 * (r >> 2); const int di = e0 - 16 * kk, dj = di - 512;
                p0[r] += lut[di < 0 ? 0 : (di > 127 ? 127 : di)]; p1[r] += lut[dj < 0 ? 0 : (dj > 127 ? 127 : dj)];
                if (di < 0) p0[r] = ATT_NEG; if (dj < 0) p1[r] = ATT_NEG; }
        }
        float rm = fmaxf(p0[0], p1[0]);
#pragma unroll
        for (int r = 1; r < 16; ++r) rm = fmaxf(rm, fmaxf(p0[r], p1[r]));
        rm = xhalf_max(rm);
        if constexpr (MODE == MODE_CMPA) { m = fmaxf(m, rm); continue; }
        if constexpr (MODE != MODE_CMPB) {
            if (__any(rm > m + 8.f)) { const float mn = fmaxf(m, rm); const float al = __builtin_amdgcn_exp2f(m - mn); m = mn; l *= al; o_rowscale(o, wsf, al, r32, hi, false, o); }
        }
        float sum = 0.f;
#pragma unroll
        for (int r = 0; r < 16; ++r) { p0[r] = __builtin_amdgcn_exp2f(p0[r] - m); p1[r] = __builtin_amdgcn_exp2f(p1[r] - m); sum += p0[r] + p1[r]; }
        l += sum;
        if constexpr (MODE == MODE_CMPB) {
            if (want_imp) { float x[4], y[4];
#pragma unroll
                for (int a = 0; a < 4; ++a) { x[a] = __shfl_xor(p0[4 * a + 3], 32); y[a] = __shfl_xor(p1[4 * a + 3], 32); }
#pragma unroll
                for (int a = 0; a < 4; ++a) {
                    const float pr0 = hi ? x[a] : (a ? x[a > 0 ? a - 1 : 0] : carry), pr1 = hi ? y[a] : (a ? y[a > 0 ? a - 1 : 0] : x[3]);
                    improw[16 * t + 2 * a + hi] = (p0[4 * a] + p0[4 * a + 1]) + (p0[4 * a + 2] + p0[4 * a + 3]) + pr0;
                    improw[16 * t + 8 + 2 * a + hi] = (p1[4 * a] + p1[4 * a + 1]) + (p1[4 * a + 2] + p1[4 * a + 3]) + pr1; }
                carry = y[3]; }
        }
        v4u w0, w1, w2, w3;
        w0.x = pk2(p0[0], p0[1]); w0.y = pk2(p0[2], p0[3]); w0.z = pk2(p0[4], p0[5]); w0.w = pk2(p0[6], p0[7]);
        w1.x = pk2(p0[8], p0[9]); w1.y = pk2(p0[10], p0[11]); w1.z = pk2(p0[12], p0[13]); w1.w = pk2(p0[14], p0[15]);
        w2.x = pk2(p1[0], p1[1]); w2.y = pk2(p1[2], p1[3]); w2.z = pk2(p1[4], p1[5]); w2.w = pk2(p1[6], p1[7]);
        w3.x = pk2(p1[8], p1[9]); w3.y = pk2(p1[10], p1[11]); w3.z = pk2(p1[12], p1[13]); w3.w = pk2(p1[14], p1[15]);
        pv(o, vb0 + cur, __builtin_bit_cast(bf16x8, w0), __builtin_bit_cast(bf16x8, w1), __builtin_bit_cast(bf16x8, w2), __builtin_bit_cast(bf16x8, w3));
    }
    ATT_LBAR();
}
__device__ __forceinline__ void store_o(LAS bf16* stg, const f32x16 (&o)[2], bf16* dst, int pitch, int lane) {
    const int r32 = lane & 31, hi = lane >> 5;
#pragma unroll
    for (int r = 0; r < 16; ++r) { const int orow = crow(r, hi);
#pragma unroll
        for (int d0 = 0; d0 < 2; ++d0) stg[orow * 64 + d0 * 32 + r32] = (bf16)(pk2(o[d0][r], 0.f) & 0xffffu); }
    LDS_WAIT();
#pragma unroll
    for (int i = 0; i < 4; ++i) { const int row = i * 8 + (lane >> 3), ch = lane & 7; const v4u v = *(const LAS v4u*)(stg + row * 64 + ch * 8); *(GAS v4u*)(dst + (size_t)row * pitch + ch * 8) = v; }
    LDS_WAIT();
}
__device__ __forceinline__ void fox_unit(Frame& F, int b, int h, int qb) {
    int tid_ = F.tid; asm volatile("" : "+v"(tid_));
    LAS unsigned char* lds = F.lds + RING_OFF; const int wid = __builtin_amdgcn_readfirstlane(tid_ >> 6), lane = tid_ & 63, r32 = lane & 31, hi = lane >> 5;
    const bf16* Z = (const bf16*)(F.ws + WS_Z); bf16* MIX = (bf16*)(F.ws + WS_MIX);
    const int q0 = 256 * qb; const size_t rowbase = (size_t)b * SEQ;
    { const GAS f32x4* src = (const GAS f32x4*)((const float*)(F.ws + WS_F2) + (size_t)(b * 12 + h) * SEQ); LAS f32x4* dst = (LAS f32x4*)(lds + A_F);
      for (int i = F.tid; i < (q0 + 256) / 4; i += NWAVES * 64) dst[i] = src[i]; }
    bf16x8 qr[4]; const bf16* qp = Z + (rowbase + q0 + 32 * wid + r32) * ZP + Z_FQ + h * 64 + hi * 8;
#pragma unroll
    for (int d0 = 0; d0 < 4; ++d0) qr[d0] = *(const GAS bf16x8*)(qp + d0 * 16);
    f32x16 o[2]; o[0] = f32x16{}; o[1] = f32x16{}; float m = -1e30f, l = 0.f;
    BrP P; P.tq = q0 + 32 * wid + r32; P.ti = 0; P.lutoff = 0; P.tdiag = 4 * qb; P.sel = 0ull; P.b31 = 0.f;
    run_branch<MODE_FOX>(lds, Z + rowbase * ZP + Z_FK + h * 64, Z + rowbase * ZP + Z_FV + h * 64, ZP, 0, 4 * qb + 4, qr, o, m, l, P, wid, lane, nullptr, false, (q0 + 32 * wid + 31) >> 6);
    l = xhalf_sum(l);
    o_rowscale(o, (LAS float*)(lds + A_WS) + wid * 64, l > 0.f ? 1.f / l : 0.f, r32, hi, false, o);
    store_o((LAS bf16*)(lds + A_OST) + wid * 2048, o, MIX + (rowbase + q0 + 32 * wid) * DM + h * 64, DM, lane);
    ATT_LBAR();
}
__device__ __forceinline__ void fox2_unit(Frame& F, int b, int h, int qb) {
    int tid_ = F.tid; asm volatile("" : "+v"(tid_));
    LAS unsigned char* lds = F.lds + RING_OFF;
    const bf16* Z = (const bf16*)(F.ws + WS_Z); bf16* MIX = (bf16*)(F.ws + WS_MIX);
    const int q0 = 256 * qb; const size_t rowbase = (size_t)b * SEQ;
    { const GAS f32x4* src = (const GAS f32x4*)((const float*)(F.ws + WS_F2) + (size_t)(b * 12 + h) * SEQ); LAS f32x4* dst = (LAS f32x4*)(lds + fx::LDS_F);
      for (int i = tid_; i < (q0 + 256) / 4; i += NWAVES * 64) dst[i] = src[i]; }
    fxf::attn_unit<8, ZP, ZP, DM>(tid_, q0, Z + (rowbase + q0) * ZP + Z_FQ + h * 64, Z + rowbase * ZP + Z_FK + h * 64, Z + rowbase * ZP + Z_FV + h * 64, MIX + (rowbase + q0) * DM + h * 64, (char*)lds);
}
#define NSA_LANE_STATE() \
    int tid_ = F.tid; asm volatile("" : "+v"(tid_)); \
    LAS unsigned char* lds = F.lds + RING_OFF; const int wid = __builtin_amdgcn_readfirstlane(tid_ >> 6), lane = tid_ & 63, r32 = lane & 31, hi = lane >> 5; \
    const bf16* Z = (const bf16*)(F.ws + WS_Z); \
    const int head = wid >> 1, h = g * 4 + head, tokl = 32 * (wid & 1) + r32, t0 = 64 * ti, tq = t0 + tokl; const size_t rowbase = (size_t)b * SEQ; \
    LAS float* wsf = (LAS float*)(lds + A_WS) + wid * 64; LAS float* otw = (LAS float*)(lds + A_OST) + wid * 2048; \
    const bf16* zq = Z + (rowbase + tq) * ZP; \
    (void)lane; (void)t0; (void)wsf; (void)otw; (void)tokl; (void)head
#define NSA_LOAD_Q() bf16x8 qr[4]; _Pragma("unroll") for (int d0 = 0; d0 < 4; ++d0) qr[d0] = *(const GAS bf16x8*)(zq + Z_NQ + h * 64 + hi * 8 + d0 * 16)
__device__ __forceinline__ unsigned long long nsa_cmp(Frame& F, int b, int g, int ti) {
    NSA_LANE_STATE(); NSA_LOAD_Q();
    const float g0 = sigm(bf1(zq[Z_NG + h * 3 + 0]));
    if (tid_ < 128) ((LAS unsigned*)(lds + A_SEL))[tid_] = 0u;
    BrP P; P.tq = tq; P.ti = ti; P.lutoff = h * 128; P.tdiag = 0; P.sel = 0ull; P.b31 = 0.f;
    const bool need_topk = ti >= 16;
    f32x16 oc[2]; oc[0] = f32x16{}; oc[1] = f32x16{}; float fc = 0.f;
    { const bf16* Kc = (const bf16*)(F.ws + WS_KCMP) + (size_t)(b * 3 + g) * 256 * 64; const bf16* Vc = (const bf16*)(F.ws + WS_VCMP) + (size_t)(b * 3 + g) * 256 * 64;
      const int nct = (4 * ti + 66) >> 6;
      float m = -1e30f, l = 0.f;
      run_branch<MODE_CMPA>(lds, Kc, Vc, 64, 0, nct, qr, oc, m, l, P, wid, lane, nullptr, false, 0);
      run_branch<MODE_CMPB>(lds, Kc, Vc, 64, 0, nct, qr, oc, m, l, P, wid, lane, (LAS float*)(lds + A_IMPRAW) + (head * 64 + tokl) * 64, need_topk, 0);
      l = xhalf_sum(l); const float linv = l > 0.f ? 1.f / l : 0.f;
      if (hi == 0) ((LAS float*)(lds + A_LINV))[head * 64 + tokl] = linv;
      fc = g0 * linv;
    }
    unsigned long long sel = (ti == 63) ? ~0ull : ((1ull << (ti + 1)) - 1ull);
    if (need_topk) {
        ATT_LBAR();
        { const int tok = tid_ >> 3, jg = (tid_ & 7) * 8; const LAS float* raw = (const LAS float*)(lds + A_IMPRAW); const LAS float* li = (const LAS float*)(lds + A_LINV);
          LAS float* imp2 = (LAS float*)(lds + A_IMP2) + tok * 65;
#pragma unroll
          for (int j = 0; j < 8; ++j) { float s = 0.f;
#pragma unroll
              for (int r = 0; r < 4; ++r) s += raw[(r * 64 + tok) * 64 + jg + j] * li[r * 64 + tok];
              imp2[jg + j] = (jg + j <= ti) ? s : 0.f; } }
        ATT_LBAR();
        { const int tok = tid_ >> 3, jg = (tid_ & 7) * 8; const LAS float* imp2 = (const LAS float*)(lds + A_IMP2) + tok * 65;
          unsigned bits = 0u;
#pragma unroll
          for (int j = 0; j < 8; ++j) { const int jj = jg + j; bool on;
              if (jj > ti) on = false;
              else if (jj == 0 || jj + 1 >= ti) on = true;
              else { const float v = imp2[jj]; int rank = 3;
                  for (int k = 1; k + 1 < ti; ++k) { const float ov = imp2[k]; rank += (ov > v || (ov == v && k < jj)) ? 1 : 0; }
                  on = rank < 16; }
              bits |= on ? (1u << j) : 0u; }
          if (bits) (void)__hip_atomic_fetch_or((LAS unsigned*)(lds + A_SEL) + tok * 2 + (jg >> 5), bits << (jg & 31), __ATOMIC_RELAXED, __HIP_MEMORY_SCOPE_WORKGROUP); }
        ATT_LBAR();
        { const LAS unsigned* sp = (const LAS unsigned*)(lds + A_SEL) + tokl * 2; sel = (unsigned long long)sp[0] | ((unsigned long long)sp[1] << 32); }
    }
    ot_update(otw, oc, wsf, fc, r32, hi, 0);
    return sel;
}
__device__ __forceinline__ void nsa_sel(Frame& F, int b, int g, int ti, unsigned long long sel) {
    NSA_LANE_STATE();
    const float g1 = sigm(bf1(zq[Z_NG + h * 3 + 1])); const float b31 = ((const LAS float*)(lds + A_LUT))[h * 128 + 127];
#ifdef X_SEL_OLD
    { NSA_LOAD_Q(); BrP P; P.tq = tq; P.ti = ti; P.lutoff = h * 128; P.tdiag = 0; P.sel = sel; P.b31 = b31;
      f32x16 o[2]; o[0] = f32x16{}; o[1] = f32x16{}; float m = -1e30f, l = 0.f;
      run_branch<MODE_SEL>(lds, Z + rowbase * ZP + Z_KS + g * 64, Z + rowbase * ZP + Z_VS + g * 64, ZP, 0, ti + 1, qr, o, m, l, P, wid, lane, nullptr, false, 0);
      l = xhalf_sum(l); ot_update(otw, o, wsf, l > 0.f ? g1 / l : 0.f, r32, hi, 1); }
#else
    { f32x16 o[2]; float l;
      fx::HookP hp; hp.tab = (const LAS float*)(lds + A_LUT) + h * 128; hp.qrel = 0; hp.ti = ti; hp.tq = tq; hp.sel = sel; hp.b31 = b31;
      fx::attn_core<8, fx::MODE_SEL, ZP>(tid_, (ti + 2) & ~1, zq + Z_NQ + h * 64, Z + rowbase * ZP + Z_KS + g * 64, Z + rowbase * ZP + Z_VS + g * 64, (char*)lds, hp, o, l);
      ot_update(otw, o, wsf, l > 0.f ? g1 / l : 0.f, r32, hi, 1); }
#endif
}
__device__ __forceinline__ void nsa_win(Frame& F, int b, int g, int ti) {
    NSA_LANE_STATE(); NSA_LOAD_Q();
    bf16* MIX = (bf16*)(F.ws + WS_MIX);
    const float g2 = sigm(bf1(zq[Z_NG + h * 3 + 2]));
    BrP P; P.tq = tq; P.ti = ti; P.lutoff = h * 128; P.tdiag = 0; P.sel = 0ull; P.b31 = ((const LAS float*)(lds + A_LUT))[h * 128 + 127];
    f32x16 o[2]; o[0] = f32x16{}; o[1] = f32x16{}; float m = -1e30f, l = 0.f;
    run_branch<MODE_WIN>(lds, Z + rowbase * ZP + Z_KW + g * 64, Z + rowbase * ZP + Z_VW + g * 64, ZP, ti >= 8 ? ti - 8 : 0, ti + 1, qr, o, m, l, P, wid, lane, nullptr, false, 0);
    l = xhalf_sum(l); ot_update(otw, o, wsf, l > 0.f ? g2 / l : 0.f, r32, hi, 2);
    store_o((LAS bf16*)otw, o, MIX + (rowbase + t0 + 32 * (wid & 1)) * DM + 768 + h * 64, DM, lane);
    ATT_LBAR();
}
__device__ __forceinline__ void nsa_unit(Frame& F, int b, int g, int ti) {
    const unsigned long long sel = nsa_cmp(F, b, g, ti);
    nsa_sel(F, b, g, ti, sel);
    nsa_win(F, b, g, ti);
}
struct OrderTab { unsigned short v[768]; };
constexpr int fox_cost(int qb) { return 4 * (qb + 1) + 1; }
constexpr int nsa_cost(int i) { return (i + 1) + (i + 1 < 9 ? i + 1 : 9) + 2 * ((4 * i + 66) >> 6) + 3; }
constexpr OrderTab make_order() {
    OrderTab T{}; int n = 0;
    for (int c = 100; c >= 0; --c) {
        for (int qb = 0; qb < 16; ++qb) if (fox_cost(qb) == c) for (int bh = 0; bh < 24; ++bh) T.v[n++] = (unsigned short)((bh << 4) | qb);
        for (int i = 0; i < 64; ++i) if (nsa_cost(i) == c) for (int bg = 0; bg < 6; ++bg) T.v[n++] = (unsigned short)(0x8000 | (bg << 6) | i);
    }
    return T;
}
__device__ const OrderTab g_order = make_order();
}
__device__ __forceinline__ void p_attn(Frame& F, KA A, int l) {
    LAS unsigned char* lds = F.lds + RING_OFF;
    { const GAS f32x4* src = (const GAS f32x4*)(F.ws + WS_LUT); LAS f32x4* dst = (LAS f32x4*)(lds + att::A_LUT); for (int i = F.tid; i < 12 * 128 / 4; i += NWAVES * 64) dst[i] = src[i]; }
    LDS_WAIT(); __syncthreads();
    LAS unsigned* qs = (LAS unsigned*)(lds + att::A_Q);
#ifndef X_NO_NSA
    if (A->flags & FL_NSA) for (;;) {
        if (F.tid == 0) qs[0] = __hip_atomic_fetch_add(F.ctl + CW_Q + 64 * l + 16, 1u, RLX_AGENT);
        LDS_WAIT(); __syncthreads();
        const unsigned qi = qs[0];
        LDS_WAIT(); __syncthreads();
        if (qi >= 384u) break;
        const int ti = 63 - (int)(qi / 6u), bg = (int)(qi % 6u);
        att::nsa_unit(F, bg / 3, bg % 3, ti);
    }
#endif
#ifndef X_NO_FOX
    if (A->flags & FL_FOX) for (;;) {
        if (F.tid == 0) qs[0] = __hip_atomic_fetch_add(F.ctl + CW_Q + 64 * l, 1u, RLX_AGENT);
        LDS_WAIT(); __syncthreads();
        const unsigned qi = qs[0];
        LDS_WAIT(); __syncthreads();
        if (qi >= 384u) break;
        const int qb = 15 - (int)(qi / 24u), bh = (int)(qi % 24u);
#ifdef X_FOX_OLD
        att::fox_unit(F, bh / 12, bh % 12, qb);
#else
        att::fox2_unit(F, bh / 12, bh % 12, qb);
#endif
    }
#endif
}
__global__ void __launch_bounds__(NWAVES * 64, 2) mk_fwd(Args args) {
    extern __shared__ __attribute__((aligned(16))) unsigned char lds[];
    Frame F;
    F.lds = (LAS unsigned char*)lds; F.MISC = (volatile LAS unsigned*)(F.lds + MISC_OFF);
    F.tid = threadIdx.x; F.lane = F.tid & 63; F.wave = __builtin_amdgcn_readfirstlane(F.tid >> 6);
    F.gw = blockIdx.x * NWAVES + F.wave; F.ngw = gridDim.x * NWAVES;
    F.ws = args.ws; F.ctl = (gu32*)(args.ws + WS_CTL);
    for (int u = F.tid; u < (LDS_BYTES - LDSCTL_OFF) / 4; u += NWAVES * 64) ((LAS unsigned*)(F.lds + LDSCTL_OFF))[u] = 0u;
    __syncthreads();
    const int lo = args.ph_lo, hi = args.ph_hi;
    XcdBarrier bar; bar.bar = (unsigned*)(F.ctl + CW_BAR); bar.x = 0; bar.st = nullptr;
    if (hi - lo > 1) bar = xcd_barrier_post((unsigned*)(F.ctl + CW_BAR), F.MISC + 8);
#define IN(k) (lo <= (k) && (k) < hi)
#define SEAM(k) do { if ((k) + 1 < hi) xcd_barrier(bar); } while (0)
#ifndef X_DUP
#define X_DUP 0
#endif
#define REP(bit) for (int rep_ = 0; rep_ < (((X_DUP) >> (bit)) & 1) + 1; ++rep_)
#define WSP(T, off) ((T*)(kargs()->ws + (off)))
#define FRESH() do { asm volatile("" : "+v"(F.tid)); { unsigned lb_ = (unsigned)(uintptr_t)F.lds; asm volatile("" : "+s"(lb_)); F.lds = (LAS unsigned char*)(uintptr_t)lb_; F.MISC = (volatile LAS unsigned*)(F.lds + MISC_OFF); } F.lane = F.tid & 63; F.wave = __builtin_amdgcn_readfirstlane(F.tid >> 6); F.gw = blockIdx.x * NWAVES + F.wave; F.ws = kargs()->ws; F.ctl = (gu32*)(F.ws + WS_CTL); } while (0)

    #ifndef X_NO_PRO
    REP(0) if (IN(PH_PRO)) { FRESH(); p_prologue(F, kargs()); SEAM(PH_PRO); }
#endif
    if (IN(PH_FIN)) { FRESH(); p_modfin(F, kargs()); SEAM(PH_FIN); }
    for (int l = 0; l < NL; ++l) {
        const int pb = PH_L0 + PH_PER_LAYER * l;
#define XIN() ((l == 0) ? kargs()->in[IN_X] : WSP(const float, WS_X))
#define MODL() (WSP(const float, WS_MOD) + (size_t)l * 2 * MODW)
        REP(1) if (IN(pb + LP_NORM1)) { FRESH(); p_norm(F, XIN(), kargs()->in[IN_N1G] + l * DM, MODL(), 0, DM, WSP(bf16, WS_XN)); SEAM(pb + LP_NORM1); }
#ifndef X_NO_GIN
        REP(2) if (IN(pb + LP_GIN)) {
            pg8::Gemm g{WSP(bf16, WS_XN), WSP(const bf16, WS_WIN) + (size_t)l * ZP * DM, MTOK, ZP, DM}; pg8::StaticOrder S; S.init(MTOK, ZP, (int)gridDim.x, (int)blockIdx.x);
            pg8::EpiZ E{WSP(bf16, WS_Z), ZP, Z_QTILES, QSCALE, Z_GLU_TILE0};
            pg8::gemm_phase<pg8::EpiZ, pg8::StaticOrder, true, true>(F.lds + RING_OFF, g, S, E);
            SEAM(pb + LP_GIN); }
#endif
#ifndef X_NO_PRE
        REP(3) if (IN(pb + LP_PRE)) { FRESH(); if (kargs()->flags & FL_PRE) p_pre(F, kargs(), l); SEAM(pb + LP_PRE); }
#endif
#ifndef X_NO_ATTN
        REP(4) if (IN(pb + LP_ATTN)) { FRESH(); p_attn(F, kargs(), l + NL * rep_); SEAM(pb + LP_ATTN); }
#endif
#ifndef X_NO_GOUT
        if (IN(pb + LP_GOUT)) {
            pg8::Gemm g{WSP(bf16, WS_MIX), WSP(const bf16, WS_WOUT) + (size_t)l * DM * DM, MTOK, DM, DM}; pg8::StaticOrder S; S.init(MTOK, DM, (int)gridDim.x, (int)blockIdx.x);
            pg8::EpiResGate E{XIN(), WSP(float, WS_X), DM, MODL() + 2 * DM, MODW, SEQ};
            pg8::gemm_phase<pg8::EpiResGate, pg8::StaticOrder, true, true>(F.lds + RING_OFF, g, S, E);
            SEAM(pb + LP_GOUT); }
#endif
        REP(1) if (IN(pb + LP_NORM2)) { FRESH(); p_norm(F, WSP(const float, WS_X), kargs()->in[IN_N2G] + l * DM, MODL(), 3 * DM, 4 * DM, WSP(bf16, WS_XN)); SEAM(pb + LP_NORM2); }
#ifndef X_NO_G1
        REP(6) if (IN(pb + LP_G1)) {
            pg8::Gemm g{WSP(bf16, WS_XN), WSP(const bf16, WS_W1) + (size_t)l * DFF * DM, MTOK, DFF, DM}; pg8::StaticOrder S; S.init(MTOK, DFF, (int)gridDim.x, (int)blockIdx.x);
            pg8::EpiRelu2 E{WSP(bf16, WS_HB), DFF};
            pg8::gemm_phase<pg8::EpiRelu2, pg8::StaticOrder, true, true>(F.lds + RING_OFF, g, S, E);
            SEAM(pb + LP_G1); }
#endif
#ifndef X_NO_G2
        if (IN(pb + LP_G2)) {
            pg8::Gemm g{WSP(bf16, WS_HB), WSP(const bf16, WS_W2) + (size_t)l * DM * DFF, MTOK, DM, DFF}; pg8::StaticOrder S; S.init(MTOK, DM, (int)gridDim.x, (int)blockIdx.x);
            pg8::EpiResGate E{WSP(const float, WS_X), WSP(float, WS_X), DM, MODL() + 5 * DM, MODW, SEQ};
            pg8::gemm_phase<pg8::EpiResGate, pg8::StaticOrder, true, true>(F.lds + RING_OFF, g, S, E);
            SEAM(pb + LP_G2); }
#endif
    }
    if (IN(PH_FINAL)) { FRESH(); p_final(F, WSP(const float, WS_X), kargs()->in[IN_FING], kargs()->out); }
#undef IN
#undef SEAM
}
#ifndef MK_MODE
#define MK_MODE 0
#endif
#ifndef MK_NAIVE
#define MK_NAIVE 0
#endif
#if MK_MODE == 2
namespace nv2 {
__device__ __forceinline__ float wmax(float v) { for (int o = 32; o; o >>= 1) v = fmaxf(v, __shfl_xor(v, o)); return v; }
__device__ __forceinline__ bf16 tobf(float v) { return (bf16)(pk2(v, 0.f) & 0xffffu); }
__global__ void __launch_bounds__(256) k_cumsum(const bf16* Z, const float* bfp, float* NF2) {
    __shared__ float sc[256];
    const int bh = blockIdx.x, b = bh / 12, h = bh % 12, tid = threadIdx.x, t0 = tid * 16;
    float run = 0.f;
    for (int i = 0; i < 16; ++i) run += logsig(bf1(Z[(size_t)(b * SEQ + t0 + i) * ZP + Z_FF + h]) + bfp[h]);
    sc[tid] = run; __syncthreads();
    float off = 0.f; for (int k = 0; k < tid; ++k) off += sc[k];
    run = off;
    for (int i = 0; i < 16; ++i) { run += logsig(bf1(Z[(size_t)(b * SEQ + t0 + i) * ZP + Z_FF + h]) + bfp[h]); NF2[(size_t)bh * SEQ + t0 + i] = -LOG2E * run; }
}
__global__ void __launch_bounds__(64) k_compress(const bf16* Z, const float* wk, const float* wv, const float* pos, bf16* KC, bf16* VC) {
    const int idx = blockIdx.x, n = idx % 256, g = (idx / 256) % 3, b = idx / (3 * 256), e = threadIdx.x;
    float ak = 0.f, av = 0.f;
    if (n < 255) for (int l = 0; l < 32; ++l) { const bf16* zr = Z + (size_t)(b * SEQ + 16 * n + l) * ZP;
        for (int d = 0; d < 64; ++d) { const float pk = pos[l * 64 + d]; ak += (bf1(zr[Z_KC + g * 64 + d]) + pk) * wk[(l * 64 + d) * 64 + e]; av += (bf1(zr[Z_VC + g * 64 + d]) + pk) * wv[(l * 64 + d) * 64 + e]; } }
    KC[(size_t)idx * 64 + e] = tobf(ak); VC[(size_t)idx * 64 + e] = tobf(av);
}
__device__ __forceinline__ float dotz(const float* q, const bf16* k) { float a = 0.f;
#pragma unroll 16
    for (int d = 0; d < 64; ++d) a += q[d] * bf1(k[d]); return a; }
__global__ void __launch_bounds__(64) k_nsa(const bf16* Z, const bf16* KC, const bf16* VC, const float* relb, bf16* MIX) {
    __shared__ float q[4][64]; __shared__ float sc[4][1024]; __shared__ float impv[64];
    const int idx = blockIdx.x, t = idx % SEQ, g = (idx / SEQ) % 3, b = idx / (3 * SEQ), lane = threadIdx.x;
    const bf16* zrow = Z + (size_t)(b * SEQ + t) * ZP;
    for (int r = 0; r < 4; ++r) q[r][lane] = bf1(zrow[Z_NQ + (g * 4 + r) * 64 + lane]);
    __syncthreads();
    float oc[4], os[4], ow[4];
    const int nvalid = t >= 31 ? ((t - 31) / 16 + 1 < 255 ? (t - 31) / 16 + 1 : 255) : 0;
    for (int n = lane; n < 256; n += 64)
        for (int r = 0; r < 4; ++r) { float s = -INFINITY;
            if (n < nvalid) s = dotz(q[r], KC + (size_t)((b * 3 + g) * 256 + n) * 64) + LOG2E * relb[t5_bucket(t - (16 * n + 31)) * 12 + g * 4 + r];
            sc[r][n] = s; }
    __syncthreads();
    for (int r = 0; r < 4; ++r) { float m = -INFINITY; for (int n = lane; n < 256; n += 64) m = fmaxf(m, sc[r][n]); m = wmax(m);
        float e[4], sum = 0.f;
#pragma unroll
        for (int i = 0; i < 4; ++i) { const float s = sc[r][lane + 64 * i]; e[i] = (s == -INFINITY) ? 0.f : exp2f(s - m); sum += e[i]; }
        sum = wave_sum(sum); const float inv = sum > 0.f ? 1.f / sum : 0.f;
#pragma unroll
        for (int i = 0; i < 4; ++i) sc[r][lane + 64 * i] = e[i] * inv; }
    __syncthreads();
#pragma unroll
    for (int r = 0; r < 4; ++r) { float a = 0.f; for (int n = 0; n < nvalid; ++n) a += sc[r][n] * bf1(VC[(size_t)((b * 3 + g) * 256 + n) * 64 + lane]); oc[r] = a; }
    { float im = 0.f; for (int r = 0; r < 4; ++r) for (int n = 4 * lane - 1; n <= 4 * lane + 3; ++n) if (n >= 0 && n < 255) im += sc[r][n];
      const int cur = t / 64; const bool forced = (lane == 0) || (lane == cur) || (lane == cur - 1); const bool valid = 64 * lane <= t;
      impv[lane] = forced ? 1e9f : (valid ? im : -1e30f); }
    __syncthreads();
    unsigned long long selm;
    { const float val = impv[lane]; int rank = 0; for (int k = 0; k < 64; ++k) { const float o = impv[k]; rank += (o > val || (o == val && k < lane)) ? 1 : 0; }
      selm = __ballot(rank < 16 && 64 * lane <= t); }
    __syncthreads();
    int nslot = 0;
    for (unsigned long long mm = selm; mm; mm &= mm - 1) { const int j = __builtin_ctzll(mm); const int tok = 64 * j + lane;
        for (int r = 0; r < 4; ++r) { float s = -INFINITY;
            if (tok <= t) s = dotz(q[r], Z + (size_t)(b * SEQ + tok) * ZP + Z_KS + g * 64) + LOG2E * relb[t5_bucket(t - tok) * 12 + g * 4 + r];
            sc[r][nslot * 64 + lane] = s; }
        ++nslot; }
    __syncthreads();
    for (int r = 0; r < 4; ++r) { float m = -INFINITY; for (int p = 0; p < nslot; ++p) m = fmaxf(m, sc[r][p * 64 + lane]); m = wmax(m);
        float sum = 0.f; for (int p = 0; p < nslot; ++p) { const float s = sc[r][p * 64 + lane]; const float e = (s == -INFINITY) ? 0.f : exp2f(s - m); sc[r][p * 64 + lane] = e; sum += e; }
        sum = wave_sum(sum); const float inv = sum > 0.f ? 1.f / sum : 0.f;
        for (int p = 0; p < nslot; ++p) sc[r][p * 64 + lane] *= inv; }
    __syncthreads();
#pragma unroll
    for (int r = 0; r < 4; ++r) os[r] = 0.f;
    { int p = 0; for (unsigned long long mm = selm; mm; mm &= mm - 1, ++p) { const int j = __builtin_ctzll(mm);
        for (int kk = 0; kk < 64; ++kk) { const float vv = bf1(Z[(size_t)(b * SEQ + 64 * j + kk) * ZP + Z_VS + g * 64 + lane]);
#pragma unroll
            for (int r = 0; r < 4; ++r) os[r] += sc[r][p * 64 + kk] * vv; } } }
    __syncthreads();
    for (int i = 0; i < 8; ++i) { const int s_ = t - 511 + lane + 64 * i;
        for (int r = 0; r < 4; ++r) { float s = -INFINITY;
            if (s_ >= 0) s = dotz(q[r], Z + (size_t)(b * SEQ + s_) * ZP + Z_KW + g * 64) + LOG2E * relb[t5_bucket(t - s_) * 12 + g * 4 + r];
            sc[r][i * 64 + lane] = s; } }
    __syncthreads();
    for (int r = 0; r < 4; ++r) { float m = -INFINITY; for (int p = 0; p < 8; ++p) m = fmaxf(m, sc[r][p * 64 + lane]); m = wmax(m);
        float sum = 0.f; for (int p = 0; p < 8; ++p) { const float s = sc[r][p * 64 + lane]; const float e = (s == -INFINITY) ? 0.f : exp2f(s - m); sc[r][p * 64 + lane] = e; sum += e; }
        sum = wave_sum(sum); const float inv = sum > 0.f ? 1.f / sum : 0.f;
        for (int p = 0; p < 8; ++p) sc[r][p * 64 + lane] *= inv; }
    __syncthreads();
#pragma unroll
    for (int r = 0; r < 4; ++r) ow[r] = 0.f;
    for (int kk = 0; kk < 512; ++kk) { const int s_ = t - 511 + kk; if (s_ < 0) continue; const float vv = bf1(Z[(size_t)(b * SEQ + s_) * ZP + Z_VW + g * 64 + lane]);
#pragma unroll
        for (int r = 0; r < 4; ++r) ow[r] += sc[r][kk] * vv; }
#pragma unroll
    for (int r = 0; r < 4; ++r) { const int h = g * 4 + r; const float g0 = sigm(bf1(zrow[Z_NG + h * 3 + 0])), g1 = sigm(bf1(zrow[Z_NG + h * 3 + 1])), g2 = sigm(bf1(zrow[Z_NG + h * 3 + 2]));
        MIX[(size_t)(b * SEQ + t) * DM + 768 + h * 64 + lane] = tobf(g0 * oc[r] + g1 * os[r] + g2 * ow[r]); }
}
__global__ void __launch_bounds__(64) k_fox(const bf16* Z, const float* NF2, bf16* MIX) {
    __shared__ float q[64]; __shared__ float sc[SEQ];
    const int idx = blockIdx.x, t = idx % SEQ, h = (idx / SEQ) % 12, b = idx / (12 * SEQ), lane = threadIdx.x;
    q[lane] = bf1(Z[(size_t)(b * SEQ + t) * ZP + Z_FQ + h * 64 + lane]);
    __syncthreads();
    const float* Fh = NF2 + (size_t)(b * 12 + h) * SEQ;
    float m = -INFINITY;
    for (int s = lane; s <= t; s += 64) { const float v = dotz(q, Z + (size_t)(b * SEQ + s) * ZP + Z_FK + h * 64) + Fh[s]; sc[s] = v; m = fmaxf(m, v); }
    m = wmax(m); float sum = 0.f;
    for (int s = lane; s <= t; s += 64) { const float e = exp2f(sc[s] - m); sc[s] = e; sum += e; }
    sum = wave_sum(sum);
    __syncthreads();
    float o = 0.f; for (int s = 0; s <= t; ++s) o += sc[s] * bf1(Z[(size_t)(b * SEQ + s) * ZP + Z_FV + h * 64 + lane]);
    MIX[(size_t)(b * SEQ + t) * DM + h * 64 + lane] = tobf(o / sum);
}
__global__ void __launch_bounds__(512) k_conv(const bf16* Z, const float* w, const float* bias, const float* lg, const float* lb, bf16* MIX) {
    __shared__ float red[8]; __shared__ float red2[8];
    const int row = blockIdx.x, b = row / SEQ, t = row % SEQ, c = threadIdx.x;
    float y = 0.f;
    for (int k = 0; k < 31; ++k) { const int tt = t - 30 + k; if (tt < 0) continue; const bf16* zr = Z + (size_t)(b * SEQ + tt) * ZP; y += bf1(zr[Z_CU + 256 * (c >> 7) + (c & 127)]) * w[k * 512 + c]; }
    y += bias[c];
    float s1 = wave_sum(y); if ((c & 63) == 0) red[c >> 6] = s1; __syncthreads();
    float mu = 0.f; for (int i = 0; i < 8; ++i) mu += red[i]; mu *= (1.f / 512.f);
    const float dy = y - mu; float s2 = wave_sum(dy * dy); if ((c & 63) == 0) red2[c >> 6] = s2; __syncthreads();
    float var = 0.f; for (int i = 0; i < 8; ++i) var += red2[i]; var *= (1.f / 512.f);
    const float yn = dy * rsqrtf(var + 1e-6f) * lg[c] + lb[c];
    MIX[(size_t)row * DM + 1536 + c] = tobf(yn * sigm(yn));
}
}
#endif

extern "C" void kernel_launch(void* const* d_in, const int* in_sizes, int n_in, void* d_out, int out_size, void* d_ws, size_t ws_size, hipStream_t stream) {
    static int grid = 0;
    if (grid == 0) {
        if (n_in != 20 || in_sizes[0] != MTOK * DM || out_size != MTOK * DM || ws_size < WS_END) { fprintf(stderr, "kernel_launch: unexpected shapes (n_in %d, in0 %d, out %d, ws %zu); nothing launched\n", n_in, n_in > 0 ? in_sizes[0] : -1, out_size, ws_size); grid = -1; return; }
        int dev = 0, cus = 0, per_cu = 0;
        if (hipGetDevice(&dev) != hipSuccess || hipDeviceGetAttribute(&cus, hipDeviceAttributeMultiprocessorCount, dev) != hipSuccess) { grid = -1; return; }
        if (hipFuncSetAttribute((const void*)mk_fwd, hipFuncAttributeMaxDynamicSharedMemorySize, LDS_BYTES) != hipSuccess) { fprintf(stderr, "kernel_launch: hipFuncSetAttribute failed\n"); grid = -1; return; }
        if (hipOccupancyMaxActiveBlocksPerMultiprocessor(&per_cu, (const void*)mk_fwd, NWAVES * 64, LDS_BYTES) != hipSuccess || per_cu < 1) { fprintf(stderr, "kernel_launch: occupancy query says %d blocks per CU\n", per_cu); }
        (void)hipGetLastError();
        grid = cus;
    }
    if (grid < 0) return;
    if (hipMemsetAsync((char*)d_ws + WS_CTL, 0, CTL_ZERO_BYTES, stream) != hipSuccess) return;
    Args a{};
    for (int i = 0; i < 20; ++i) a.in[i] = (const float*)d_in[i];
    a.out = (float*)d_out; a.ws = (unsigned char*)d_ws; a.flags = FL_FOX | FL_NSA | FL_PRE; a.pad = 0;
#if MK_MODE == 0
    a.ph_lo = 0; a.ph_hi = NPH;
    hipLaunchKernelGGL(mk_fwd, dim3(grid), dim3(NWAVES * 64), LDS_BYTES, stream, a);
#else
#if MK_MODE == 2
    if (MK_NAIVE & 1) a.flags &= ~FL_PRE;
    if (MK_NAIVE & 2) a.flags &= ~FL_FOX;
    if (MK_NAIVE & 4) a.flags &= ~FL_NSA;
    unsigned char* ws = (unsigned char*)d_ws; const bf16* Zb = (const bf16*)(ws + WS_Z); bf16* MIXb = (bf16*)(ws + WS_MIX); float* NF2 = (float*)(ws + WS_F2); bf16* KC = (bf16*)(ws + WS_KCMP); bf16* VC = (bf16*)(ws + WS_VCMP);
#endif
    for (int p = 0; p < NPH; ++p) {
        a.ph_lo = p; a.ph_hi = p + 1;
        hipLaunchKernelGGL(mk_fwd, dim3(grid), dim3(NWAVES * 64), LDS_BYTES, stream, a);
#if MK_MODE == 2
        const int lp = (p - PH_L0) % PH_PER_LAYER, l = (p - PH_L0) / PH_PER_LAYER;
        if (p >= PH_L0 && p < PH_FINAL && lp == LP_PRE && (MK_NAIVE & 1)) {
            hipLaunchKernelGGL(nv2::k_cumsum, dim3(NB * 12), dim3(256), 0, stream, Zb, a.in[IN_BF] + l * 12, NF2);
            hipLaunchKernelGGL(nv2::k_compress, dim3(NB * 3 * 256), dim3(64), 0, stream, Zb, a.in[IN_WCK] + (size_t)l * 32 * 64 * 64, a.in[IN_WCV] + (size_t)l * 32 * 64 * 64, a.in[IN_POS] + l * 32 * 64, KC, VC);
            hipLaunchKernelGGL(nv2::k_conv, dim3(MTOK), dim3(512), 0, stream, Zb, a.in[IN_CW] + (size_t)l * 31 * 512, a.in[IN_CB] + l * 512, a.in[IN_CLG] + l * 512, a.in[IN_CLB] + l * 512, MIXb); }
        if (p >= PH_L0 && p < PH_FINAL && lp == LP_ATTN) {
            if (MK_NAIVE & 2) hipLaunchKernelGGL(nv2::k_fox, dim3(NB * 12 * SEQ), dim3(64), 0, stream, Zb, NF2, MIXb);
            if (MK_NAIVE & 4) hipLaunchKernelGGL(nv2::k_nsa, dim3(NB * 3 * SEQ), dim3(64), 0, stream, Zb, KC, VC, a.in[IN_RELB], MIXb); }
#endif
    }
#endif
}
```
